# Optimizing an MI355X kernel written in HIP

```python
import math
import jax
import jax.numpy as jnp
from jax import lax
import numpy as np

D_MODEL = 2048
BATCH = 8
SEQ = 2048
DEPTH = 4

CTX_LEN = 256
GRID_W = 64
HEAD_DIM = 128
N_HEAD_SLOTS = D_MODEL // HEAD_DIM
GDN_HEADS = N_HEAD_SLOTS // 2
GDN_DK = HEAD_DIM
GDN_DV = HEAD_DIM
GDN_CONV = 3
GDN_CHUNK = 64
DIFF_HEADS = N_HEAD_SLOTS // 2
DIFF_DH = HEAD_DIM // 2
Q_BLOCK = 128
NA_HEADS = N_HEAD_SLOTS // 2
NA_ROWS = 8
NA_COLS = 16
NA_QCOLS = 16
NA_KSPAN = 32
WIN_HEADS = N_HEAD_SLOTS // 2
WIN_KV_HEADS = 2
WIN = 128
WIN_BLOCK = 128
FFN_HIDDEN = -(-8 * D_MODEL // (3 * 256)) * 256
ROPE_BASE = 10000.0
NORM_EPS = 1e-6

GDN_QKV = GDN_HEADS * (2 * GDN_DK + GDN_DV)
EVEN_WIDTHS = (GDN_QKV, GDN_HEADS * GDN_DV, 2 * GDN_HEADS, 2 * GDN_HEADS,
               DIFF_HEADS * 2 * DIFF_DH, DIFF_HEADS * 2 * DIFF_DH, DIFF_HEADS * 2 * DIFF_DH)
ODD_WIDTHS = (NA_HEADS * HEAD_DIM, NA_HEADS * HEAD_DIM, NA_HEADS * HEAD_DIM,
              WIN_HEADS * HEAD_DIM, WIN_KV_HEADS * HEAD_DIM, WIN_KV_HEADS * HEAD_DIM)

kernel_name = 'hybrid_gdn_diff_natten_swa_dit_trunk'


def rmsnorm(x, g):
    xf = x.astype(jnp.float32)
    y = xf * lax.rsqrt(jnp.mean(xf * xf, axis=-1, keepdims=True) + NORM_EPS)
    return (y * g.astype(jnp.float32)).astype(x.dtype)


def l2norm(x):
    xf = x.astype(jnp.float32)
    return (xf * lax.rsqrt(jnp.sum(xf * xf, axis=-1, keepdims=True) + NORM_EPS)).astype(x.dtype)


def split_cols(p, widths):
    return jnp.split(p, np.cumsum(widths)[:-1].tolist(), axis=-1)


def _rope_axis(x, pos):
    n = x.shape[-1]
    inv = ROPE_BASE ** (-jnp.arange(0, n, 2, dtype=jnp.float32) / n)
    ang = pos.astype(jnp.float32)[:, None] * inv[None, :]
    bshape = (pos.shape[0],) + (1,) * (x.ndim - 3) + (n // 2,)
    cos = jnp.cos(ang).reshape(bshape).astype(x.dtype)
    sin = jnp.sin(ang).reshape(bshape).astype(x.dtype)
    x1, x2 = x[..., : n // 2], x[..., n // 2:]
    return jnp.concatenate([x1 * cos - x2 * sin, x2 * cos + x1 * sin], axis=-1)


def rope2d(x, rows, cols):
    d = x.shape[-1]
    return jnp.concatenate([_rope_axis(x[..., : d // 2], rows), _rope_axis(x[..., d // 2:], cols)], axis=-1)


def short_conv(x, w):
    k = w.shape[0]
    return lax.conv_general_dilated(x, w[:, None, :].astype(x.dtype), window_strides=(1,),
                                    padding=[(k // 2, k // 2)], dimension_numbers=('NWC', 'WIO', 'NWC'),
                                    feature_group_count=x.shape[-1])


def gated_delta_chunked(q, k, v, g, beta, s0):
    bsz, n, h, dk = q.shape
    dv = v.shape[-1]
    c = GDN_CHUNK
    nc = n // c

    def chunks(a):
        a = a.astype(jnp.float32).reshape((bsz, nc, c, h) + a.shape[3:])
        return jnp.moveaxis(a, 3, 1)

    qc = chunks(q) * dk ** -0.5
    kc = chunks(k)
    vc = chunks(v)
    bc = chunks(beta)
    gc = jnp.cumsum(chunks(g), axis=-1)
    tril = jnp.asarray(np.tril(np.ones((c, c), bool)))
    strict = jnp.asarray(np.tril(np.ones((c, c), bool), -1))
    decay = jnp.exp(jnp.where(tril, gc[..., :, None] - gc[..., None, :], -jnp.inf))
    kb = kc * bc[..., None]
    a_mat = jnp.where(strict, jnp.einsum('bhnid,bhnjd->bhnij', kb, kc) * decay, 0.0)
    eye = jnp.eye(c, dtype=jnp.float32)
    t_mat = lax.linalg.triangular_solve(eye + a_mat, jnp.broadcast_to(eye, a_mat.shape),
                                        left_side=True, lower=True)
    u = jnp.einsum('bhnij,bhnjd->bhnid', t_mat, vc * bc[..., None])
    w = jnp.einsum('bhnij,bhnjd->bhnid', t_mat, kb * jnp.exp(gc)[..., None])
    attn = jnp.where(tril, jnp.einsum('bhnid,bhnjd->bhnij', qc, kc) * decay, 0.0)
    qg = qc * jnp.exp(gc)[..., None]
    kdec = kc * jnp.exp(gc[..., -1:] - gc)[..., None]
    g_last = jnp.exp(gc[..., -1])

    def step(s, xs):
        qg_i, kdec_i, u_i, w_i, attn_i, gl_i = xs
        v_new = u_i - jnp.einsum('bhcd,bhde->bhce', w_i, s)
        o_i = jnp.einsum('bhcd,bhde->bhce', qg_i, s) + jnp.einsum('bhij,bhje->bhie', attn_i, v_new)
        s = s * gl_i[..., None, None] + jnp.einsum('bhcd,bhce->bhde', kdec_i, v_new)
        return s, o_i

    xs = tuple(jnp.moveaxis(a, 2, 0) for a in (qg, kdec, u, w, attn, g_last))
    s_fin, o = lax.scan(step, s0.astype(jnp.float32), xs)
    o = jnp.moveaxis(o, 0, 2).reshape(bsz, h, n, dv).transpose(0, 2, 1, 3)
    return o.astype(v.dtype), s_fin


def gdn_bidirectional(q, k, v, g, beta, qc, kc, vc, gc, betac):
    bsz, _, h, dk = q.shape
    s0 = jnp.zeros((bsz, h, dk, v.shape[-1]), jnp.float32)
    flip = lambda a: jnp.flip(a, axis=1)
    oc_f, sc_f = gated_delta_chunked(qc, kc, vc, gc[:, :, 0], betac[:, :, 0], s0)
    o_f, _ = gated_delta_chunked(q, k, v, g[:, :, 0], beta[:, :, 0], sc_f)
    oc_b, sc_b = gated_delta_chunked(flip(qc), flip(kc), flip(vc), flip(gc[:, :, 1]), flip(betac[:, :, 1]), s0)
    o_b, _ = gated_delta_chunked(flip(q), flip(k), flip(v), flip(g[:, :, 1]), flip(beta[:, :, 1]), sc_b)
    return o_f + flip(o_b), oc_f + flip(oc_b)


def diff_attention(q, k, v, qc, kc, vc, lam, rows, cols, need_ctx):
    bsz, n, h = q.shape[:3]
    q = rope2d(q, rows, cols)
    k = rope2d(k, rows, cols)
    k_all = jnp.concatenate([k, kc], axis=1)
    v_all = jnp.concatenate([v, vc], axis=1)
    scale = q.shape[-1] ** -0.5

    def attend(qb, kk, vv):
        s = jnp.einsum('bqhcd,bkhcd->bhcqk', qb, kk).astype(jnp.float32) * scale
        p = jax.nn.softmax(s, axis=-1)
        a = (p[:, :, 0] - lam * p[:, :, 1]).astype(vv.dtype)
        return jnp.einsum('bhqk,bkhe->bqhe', a, vv)

    qb = jnp.moveaxis(q.reshape((bsz, n // Q_BLOCK, Q_BLOCK) + q.shape[2:]), 1, 0)
    o = lax.map(lambda blk: attend(blk, k_all, v_all), qb)
    o = jnp.moveaxis(o, 0, 1).reshape(bsz, n, h, v.shape[-1])
    oc = attend(qc, kc, vc) if need_ctx else None
    return o, oc


def neighbourhood_attention(q, k, v, kc, vc, rpb):
    bsz, n, h, d = q.shape
    n_rows = n // GRID_W
    kr = min(NA_ROWS, n_rows)
    scale = d ** -0.5
    ncb = GRID_W // NA_QCOLS
    q_cols = np.arange(GRID_W).reshape(ncb, NA_QCOLS)
    win_c = np.clip(q_cols - NA_COLS // 2, 0, GRID_W - NA_COLS)
    span0 = np.clip(np.arange(ncb) * NA_QCOLS - NA_COLS // 2, 0, GRID_W - NA_KSPAN)
    key_cols = span0[:, None] + np.arange(NA_KSPAN)
    kcol = key_cols[:, None, :]
    col_ok = (kcol >= win_c[..., None]) & (kcol < win_c[..., None] + NA_COLS)
    dc_idx = np.clip(kcol - q_cols[..., None] + NA_COLS - 1, 0, 2 * NA_COLS - 2)
    nl = kr * NA_KSPAN
    mask = jnp.asarray(np.broadcast_to(col_ok[:, :, None, :], (ncb, NA_QCOLS, kr, NA_KSPAN)).reshape(ncb, NA_QCOLS, nl))
    rpb_c = rpb[:, :, dc_idx]
    kg = k.reshape(bsz, n_rows, GRID_W, h, d)
    vg = v.reshape(bsz, n_rows, GRID_W, h, d)

    def row_block(args):
        r, q_r = args
        start = jnp.clip(r - kr // 2, 0, n_rows - kr)

        def gather(a):
            a = lax.dynamic_slice_in_dim(a, start, kr, axis=1)[:, :, key_cols]
            return a.transpose(0, 2, 1, 3, 4, 5).reshape(bsz, ncb, nl, h, d)

        k_r, v_r = gather(kg), gather(vg)
        q_b = q_r.reshape(bsz, ncb, NA_QCOLS, h, d)
        dr_idx = start + jnp.arange(kr) - r + NA_ROWS - 1
        bias = rpb_c[:, dr_idx].transpose(0, 2, 3, 1, 4).reshape(h, ncb, NA_QCOLS, nl)
        s_loc = jnp.einsum('bnqhd,bnkhd->bhnqk', q_b, k_r).astype(jnp.float32) * scale + bias
        s_loc = jnp.where(mask, s_loc, -jnp.inf)
        s_ctx = jnp.einsum('bnqhd,bkhd->bhnqk', q_b, kc).astype(jnp.float32) * scale
        p = jax.nn.softmax(jnp.concatenate([s_loc, s_ctx], axis=-1), axis=-1).astype(v.dtype)
        o = (jnp.einsum('bhnqk,bnkhd->bnqhd', p[..., :nl], v_r)
             + jnp.einsum('bhnqk,bkhd->bnqhd', p[..., nl:], vc))
        return o.reshape(bsz, GRID_W, h, d)

    qg = jnp.moveaxis(q.reshape(bsz, n_rows, GRID_W, h, d), 1, 0)
    o = lax.map(row_block, (jnp.arange(n_rows), qg))
    return jnp.moveaxis(o, 0, 1).reshape(bsz, n, h, d)


def context_attention(qc, kc, vc):
    s = jnp.einsum('bqhd,bkhd->bhqk', qc, kc).astype(jnp.float32) * qc.shape[-1] ** -0.5
    p = jax.nn.softmax(s, axis=-1).astype(vc.dtype)
    return jnp.einsum('bhqk,bkhd->bqhd', p, vc)


def window_sink_attention(q, k, v, kc, vc, sink, rows, cols):
    bsz, n, h, d = q.shape
    kvh = k.shape[2]
    grp = h // kvh
    q = rope2d(q, rows, cols)
    k = rope2d(k, rows, cols)
    scale = d ** -0.5
    nb = n // WIN_BLOCK

    def band(a):
        ap = jnp.pad(a, ((0, 0), (WIN_BLOCK, WIN_BLOCK), (0, 0), (0, 0))).reshape(bsz, nb + 2, WIN_BLOCK, kvh, d)
        return jnp.concatenate([ap[:, :-2], ap[:, 1:-1], ap[:, 2:]], axis=2)

    kb, vb = band(k), band(v)
    qb = q.reshape(bsz, nb, WIN_BLOCK, kvh, grp, d)
    qpos = jnp.arange(n).reshape(nb, WIN_BLOCK)
    kpos = (jnp.arange(nb) * WIN_BLOCK - WIN_BLOCK)[:, None] + jnp.arange(3 * WIN_BLOCK)[None, :]
    kp = kpos[:, None, :]
    valid = (kp >= 0) & (kp < n) & (jnp.abs(qpos[:, :, None] - kp) <= WIN)
    s_loc = jnp.where(valid, jnp.einsum('bnqhgd,bnkhd->bhgnqk', qb, kb).astype(jnp.float32) * scale, -jnp.inf)
    s_ctx = jnp.einsum('bnqhgd,bkhd->bhgnqk', qb, kc).astype(jnp.float32) * scale
    sink_l = jnp.broadcast_to(sink.astype(jnp.float32).reshape(1, kvh, grp, 1, 1, 1), s_ctx.shape[:-1] + (1,))
    p = jax.nn.softmax(jnp.concatenate([s_loc, s_ctx, sink_l], axis=-1), axis=-1).astype(v.dtype)
    nl = 3 * WIN_BLOCK
    o = (jnp.einsum('bhgnqk,bnkhd->bnqhgd', p[..., :nl], vb)
         + jnp.einsum('bhgnqk,bkhd->bnqhgd', p[..., nl:-1], vc))
    return o.reshape(bsz, n, h, d)


def context_sink_attention(qc, kc, vc, sink):
    bsz, m, h, d = qc.shape
    kvh = kc.shape[2]
    grp = h // kvh
    qg = qc.reshape(bsz, m, kvh, grp, d)
    s = jnp.einsum('bqhgd,bkhd->bhgqk', qg, kc).astype(jnp.float32) * d ** -0.5
    sink_l = jnp.broadcast_to(sink.astype(jnp.float32).reshape(1, kvh, grp, 1, 1), s.shape[:-1] + (1,))
    p = jax.nn.softmax(jnp.concatenate([s, sink_l], axis=-1), axis=-1).astype(vc.dtype)[..., :-1]
    return jnp.einsum('bhgqk,bkhd->bqhgd', p, vc).reshape(bsz, m, h, d)


def swiglu(u, wg, wu, wd):
    return (jax.nn.silu(u @ wg) * (u @ wu)) @ wd


def even_mixer(u, uc, w_in, conv_w, a_log, dt_bias, gdn_g, lam_q1, lam_k1, lam_q2, lam_k2, subln_g,
               lambda_init, rows, cols, need_ctx):
    def project(t):
        bsz, n = t.shape[:2]
        qkv, z, a, b, dq, dk, dv = split_cols(t @ w_in, EVEN_WIDTHS)
        qkv = jax.nn.silu(short_conv(qkv, conv_w))
        gq, gk, gv = split_cols(qkv, (GDN_HEADS * GDN_DK, GDN_HEADS * GDN_DK, GDN_HEADS * GDN_DV))
        gq = l2norm(gq.reshape(bsz, n, GDN_HEADS, GDN_DK))
        gk = l2norm(gk.reshape(bsz, n, GDN_HEADS, GDN_DK))
        gv = gv.reshape(bsz, n, GDN_HEADS, GDN_DV)
        g = -jnp.exp(a_log.astype(jnp.float32)) * jax.nn.softplus(
            a.reshape(bsz, n, 2, GDN_HEADS).astype(jnp.float32) + dt_bias.astype(jnp.float32))
        beta = jax.nn.sigmoid(b.reshape(bsz, n, 2, GDN_HEADS).astype(jnp.float32))
        gdn = (gq, gk, gv, g, beta, z.reshape(bsz, n, GDN_HEADS, GDN_DV))
        diff = (dq.reshape(bsz, n, DIFF_HEADS, 2, DIFF_DH), dk.reshape(bsz, n, DIFF_HEADS, 2, DIFF_DH),
                dv.reshape(bsz, n, DIFF_HEADS, 2 * DIFF_DH))
        return gdn, diff

    (q, k, v, g, beta, z), (dq, dk, dv) = project(u)
    (qc, kc, vc, gc, betac, zc), (dqc, dkc, dvc) = project(uc)
    o, oc = gdn_bidirectional(q, k, v, g, beta, qc, kc, vc, gc, betac)
    lam = (jnp.exp(jnp.sum(lam_q1.astype(jnp.float32) * lam_k1.astype(jnp.float32)))
           - jnp.exp(jnp.sum(lam_q2.astype(jnp.float32) * lam_k2.astype(jnp.float32))) + lambda_init)
    d_o, d_oc = diff_attention(dq, dk, dv, dqc, dkc, dvc, lam, rows, cols, need_ctx)

    def merge(o_gdn, zz, o_diff):
        bsz, n = o_gdn.shape[:2]
        a_out = rmsnorm(o_gdn, gdn_g) * jax.nn.silu(zz)
        b_out = rmsnorm(o_diff, subln_g) * (1.0 - lambda_init)
        return jnp.concatenate([a_out.reshape(bsz, n, -1), b_out.reshape(bsz, n, -1)], axis=-1)

    y = merge(o, z, d_o)
    yc = merge(oc, zc, d_oc) if need_ctx else None
    return y, yc


def odd_mixer(u, uc, w_in, rpb, sink, rows, cols, need_ctx):
    def project(t):
        bsz, n = t.shape[:2]
        nq, nk, nv, wq, wk, wv = split_cols(t @ w_in, ODD_WIDTHS)
        hd = lambda a, nh: a.reshape(bsz, n, nh, HEAD_DIM)
        return ((hd(nq, NA_HEADS), hd(nk, NA_HEADS), hd(nv, NA_HEADS)),
                (hd(wq, WIN_HEADS), hd(wk, WIN_KV_HEADS), hd(wv, WIN_KV_HEADS)))

    (nq, nk, nv), (wq, wk, wv) = project(u)
    (nqc, nkc, nvc), (wqc, wkc, wvc) = project(uc)
    bsz, n = u.shape[:2]
    c_out = neighbourhood_attention(nq, nk, nv, nkc, nvc, rpb)
    d_out = window_sink_attention(wq, wk, wv, wkc, wvc, sink, rows, cols)
    y = jnp.concatenate([c_out.reshape(bsz, n, -1), d_out.reshape(bsz, n, -1)], axis=-1)
    yc = None
    if need_ctx:
        m = uc.shape[1]
        cc = context_attention(nqc, nkc, nvc)
        dc = context_sink_attention(wqc, wkc, wvc, sink)
        yc = jnp.concatenate([cc.reshape(bsz, m, -1), dc.reshape(bsz, m, -1)], axis=-1)
    return y, yc


def setup_inputs(seed: int = 0) -> dict:
    key = jax.random.key(seed)
    ks = list(jax.random.split(key, 28))
    n_even = (DEPTH + 1) // 2
    n_odd = DEPTH // 2
    f32 = jnp.float32
    d = D_MODEL

    def nrm(k, shape, std):
        return jax.random.normal(k, shape, f32) * std

    dt = jnp.exp(jax.random.uniform(ks[9], (n_even, 2, GDN_HEADS), f32, math.log(1e-3), math.log(1e-1)))
    dt_bias = dt + jnp.log(-jnp.expm1(-dt))
    return {
        'x': nrm(ks[0], (BATCH, SEQ, d), 1.0),
        'c': nrm(ks[1], (BATCH, d), 1.0),
        'ctx': nrm(ks[2], (BATCH, CTX_LEN, d), 1.0),
        'c_ctx': nrm(ks[3], (d,), 1.0),
        'ada_w': nrm(ks[4], (DEPTH, d, 6 * d), 0.5 * d ** -0.5),
        'ada_b': nrm(ks[5], (DEPTH, 6 * d), 0.02),
        'norm_mix_g': 1.0 + nrm(ks[6], (DEPTH, d), 0.02),
        'norm_ffn_g': 1.0 + nrm(ks[7], (DEPTH, d), 0.02),
        'w_in_even': nrm(ks[8], (n_even, d, sum(EVEN_WIDTHS)), d ** -0.5),
        'gdn_conv_w': nrm(ks[10], (n_even, GDN_CONV, GDN_QKV), GDN_CONV ** -0.5),
        'gdn_a_log': jnp.log(jax.random.uniform(ks[11], (n_even, 2, GDN_HEADS), f32, 1.0, 16.0)),
        'gdn_dt_bias': dt_bias,
        'gdn_norm_g': 1.0 + nrm(ks[12], (n_even, GDN_DV), 0.02),
        'diff_lambda_q1': nrm(ks[13], (n_even, DIFF_DH), 0.1),
        'diff_lambda_k1': nrm(ks[14], (n_even, DIFF_DH), 0.1),
        'diff_lambda_q2': nrm(ks[15], (n_even, DIFF_DH), 0.1),
        'diff_lambda_k2': nrm(ks[16], (n_even, DIFF_DH), 0.1),
        'diff_subln_g': 1.0 + nrm(ks[17], (n_even, 2 * DIFF_DH), 0.02),
        'w_in_odd': nrm(ks[18], (n_odd, d, sum(ODD_WIDTHS)), d ** -0.5),
        'na_rpb': nrm(ks[19], (n_odd, NA_HEADS, 2 * NA_ROWS - 1, 2 * NA_COLS - 1), 0.1),
        'win_sink': nrm(ks[20], (n_odd, WIN_HEADS), 0.5),
        'w_out': nrm(ks[21], (DEPTH, d, d), d ** -0.5),
        'ffn_w_gate': nrm(ks[22], (DEPTH, d, FFN_HIDDEN), d ** -0.5),
        'ffn_w_up': nrm(ks[23], (DEPTH, d, FFN_HIDDEN), d ** -0.5),
        'ffn_w_down': nrm(ks[24], (DEPTH, FFN_HIDDEN, d), FFN_HIDDEN ** -0.5),
        'final_norm_g': 1.0 + nrm(ks[25], (d,), 0.02),
    }


def reference(x, c, ctx, c_ctx, ada_w, ada_b, norm_mix_g, norm_ffn_g,
              w_in_even, gdn_conv_w, gdn_a_log, gdn_dt_bias, gdn_norm_g,
              diff_lambda_q1, diff_lambda_k1, diff_lambda_q2, diff_lambda_k2, diff_subln_g,
              w_in_odd, na_rpb, win_sink, w_out, ffn_w_gate, ffn_w_up, ffn_w_down, final_norm_g):
    n = x.shape[1]
    pos = jnp.arange(n)
    rows, cols = pos // GRID_W, pos % GRID_W
    h, hc = x, ctx
    c_act = jax.nn.silu(c)
    cc_act = jax.nn.silu(c_ctx)
    for l in range(DEPTH):
        need_ctx = l < DEPTH - 1
        mod = jnp.split((c_act @ ada_w[l] + ada_b[l])[:, None, :], 6, axis=-1)
        modc = jnp.split(cc_act @ ada_w[l] + ada_b[l], 6, axis=-1)
        u = rmsnorm(h, norm_mix_g[l]) * (1.0 + mod[1]) + mod[0]
        uc = rmsnorm(hc, norm_mix_g[l]) * (1.0 + modc[1]) + modc[0]
        i = l // 2
        if l % 2 == 0:
            y, yc = even_mixer(u, uc, w_in_even[i], gdn_conv_w[i], gdn_a_log[i], gdn_dt_bias[i], gdn_norm_g[i],
                               diff_lambda_q1[i], diff_lambda_k1[i], diff_lambda_q2[i], diff_lambda_k2[i],
                               diff_subln_g[i], 0.8 - 0.6 * math.exp(-0.3 * l), rows, cols, need_ctx)
        else:
            y, yc = odd_mixer(u, uc, w_in_odd[i], na_rpb[i], win_sink[i], rows, cols, need_ctx)
        h = h + mod[2] * (y @ w_out[l])
        u2 = rmsnorm(h, norm_ffn_g[l]) * (1.0 + mod[4]) + mod[3]
        h = h + mod[5] * swiglu(u2, ffn_w_gate[l], ffn_w_up[l], ffn_w_down[l])
        if need_ctx:
            hc = hc + modc[2] * (yc @ w_out[l])
            u2c = rmsnorm(hc, norm_ffn_g[l]) * (1.0 + modc[4]) + modc[3]
            hc = hc + modc[5] * swiglu(u2c, ffn_w_gate[l], ffn_w_up[l], ffn_w_down[l])
    return rmsnorm(h, final_norm_g)
```

```cpp
#include <cstdio>
#include <cstring>
#include <hip/hip_runtime.h>
#include <cmath>
#include <cstdint>

#define HD __host__ __device__ __forceinline__

typedef unsigned short bf16_t;
#ifdef ACT_F32
typedef float act_t;
HD float ldf(const float* p) { return *p; }
HD void stf(float* p, float v) { *p = v; }
#else
typedef bf16_t act_t;
#endif
HD float bf2f(bf16_t v) { return __builtin_bit_cast(float, ((unsigned)v) << 16); }
HD bf16_t f2bf(float f) { unsigned u = __builtin_bit_cast(unsigned, f); return (bf16_t)((u + 0x7fffu + ((u >> 16) & 1u)) >> 16); }
HD float ldf(const bf16_t* p) { return bf2f(*p); }
HD void stf(bf16_t* p, float v) { *p = f2bf(v); }

struct Dims {
    int D, B, S, CTX, FF, HS, DEPTH;
    int ML, MC, M;
    int NPE, NPO;
    int PQ, PK, PV, PZ, PDQ, PDK, PDV, PA, PB;
    int PNQ, PNK, PNV, PWQ, PWK, PWV;
    int ABW;
    int GR;
};
HD Dims make_dims(int D, int B, int S, int CTX, int DEPTH) {
    Dims d; d.D = D; d.B = B; d.S = S; d.CTX = CTX; d.DEPTH = DEPTH; d.HS = D / 256;
    d.FF = ((8 * D + 3 * 256 - 1) / (3 * 256)) * 256;
    d.ML = B * S; d.MC = B * CTX; d.M = d.ML + d.MC;
    const int H1 = d.HS * 128;
    d.PQ = 0; d.PK = H1; d.PV = 2 * H1; d.PZ = 3 * H1; d.PDQ = 4 * H1; d.PDK = 5 * H1; d.PDV = 6 * H1; d.PA = 7 * H1; d.PB = 7 * H1 + 2 * d.HS;
    d.NPE = ((7 * H1 + 4 * d.HS + 255) / 256) * 256;
    d.PNQ = 0; d.PNK = H1; d.PNV = 2 * H1; d.PWQ = 3 * H1; d.PWK = 4 * H1; d.PWV = 4 * H1 + 256;
    d.NPO = ((4 * H1 + 512 + 255) / 256) * 256;
    d.ABW = 4 * d.HS; d.GR = S / 64;
    return d;
}

struct Params {
    const float *x, *c, *ctx, *c_ctx, *ada_w, *ada_b, *norm_mix_g, *norm_ffn_g, *w_in_even, *gdn_conv_w, *gdn_a_log, *gdn_dt_bias, *gdn_norm_g,
                *lq1, *lk1, *lq2, *lk2, *subln_g, *w_in_odd, *na_rpb, *win_sink, *w_out, *ffn_wg, *ffn_wu, *ffn_wd, *final_g;
    float* out;
    unsigned* ctl;
    float* modv;
    act_t *wt_in, *wt_out, *wt_gu, *wt_dn;
    float* h;
    act_t* u;
    act_t* proj;
    float* ab;
    act_t* y;
    act_t* hid;
    float *qkvact;
    float *gbuf, *betabuf;
    float *dqr, *dkr;
    float *ogdn;
    float *odiff;
    float *wqr;
    float *wkr;
};

HD float silu_f(float x) { return x / (1.0f + expf(-x)); }
HD float sigmoid_f(float x) { return 1.0f / (1.0f + expf(-x)); }
HD float softplus_f(float x) { return x > 20.f ? x : log1pf(expf(x)); }
HD float lambda_init_of(int l) { return 0.8f - 0.6f * expf(-0.3f * (float)l); }

struct RowInfo { int lat, b, t, Tn, base; };
HD RowInfo row_info(const Dims& d, int row) {
    RowInfo r;
    if (row < d.ML) { r.lat = 1; r.b = row / d.S; r.t = row % d.S; r.Tn = d.S; r.base = r.b * d.S; }
    else { const int rr = row - d.ML; r.lat = 0; r.b = rr / d.CTX; r.t = rr % d.CTX; r.Tn = d.CTX; r.base = d.ML + r.b * d.CTX; }
    return r;
}

HD void st_mod(const Params& P, const Dims& d, int, long gid, long nth) {
    const long total = (long)d.DEPTH * (d.B + 1) * 6 * d.D;
    for (long i = gid; i < total; i += nth) {
        const int n = (int)(i % (6 * d.D)); const int b9 = (int)((i / (6 * d.D)) % (d.B + 1)); const int l = (int)(i / ((long)6 * d.D * (d.B + 1)));
        const float* cv = b9 < d.B ? P.c + (size_t)b9 * d.D : P.c_ctx;
        const float* w = P.ada_w + (size_t)l * d.D * 6 * d.D + n;
        float acc = 0.f;
        for (int k = 0; k < d.D; ++k) acc += silu_f(cv[k]) * w[(size_t)k * 6 * d.D];
        P.modv[i] = acc + P.ada_b[(size_t)l * 6 * d.D + n];
    }
}
HD void st_copy_h(const Params& P, const Dims& d, int, long gid, long nth) {
    const long nl = (long)d.ML * d.D, total = (long)d.M * d.D;
    for (long i = gid; i < total; i += nth) P.h[i] = i < nl ? P.x[i] : P.ctx[i - nl];
}
enum WKind { WK_IN_EVEN = 0, WK_IN_ODD = 1, WK_OUT = 2, WK_GATE = 3, WK_UP = 4, WK_DOWN = 5 };
HD int w_dstrow(const Dims& d, int kind, int j) {
    if (kind == WK_IN_EVEN) { const int H1 = d.HS * 128;
        if (j < 4 * H1) return j;
        if (j < 4 * H1 + 4 * d.HS) return d.PA + (j - 4 * H1);
        return d.PDQ + (j - 4 * H1 - 4 * d.HS); }
    if (kind == WK_GATE) return (j / 128) * 256 + (j % 128);
    if (kind == WK_UP) return (j / 128) * 256 + 128 + (j % 128);
    return j;
}
HD void w_src(const Params& P, const Dims& d, int kind, int layer, const float*& W, int& K, int& N, act_t*& dst) {
    const int i = layer / 2;
    switch (kind) {
        case WK_IN_EVEN: K = d.D; N = 7 * d.HS * 128 + 4 * d.HS; W = P.w_in_even + (size_t)i * K * N; dst = P.wt_in; break;
        case WK_IN_ODD:  K = d.D; N = 4 * d.HS * 128 + 512; W = P.w_in_odd + (size_t)i * K * N; dst = P.wt_in; break;
        case WK_OUT:     K = d.D; N = d.D; W = P.w_out + (size_t)layer * K * N; dst = P.wt_out; break;
        case WK_GATE:    K = d.D; N = d.FF; W = P.ffn_wg + (size_t)layer * K * N; dst = P.wt_gu; break;
        case WK_UP:      K = d.D; N = d.FF; W = P.ffn_wu + (size_t)layer * K * N; dst = P.wt_gu; break;
        default:         K = d.FF; N = d.D; W = P.ffn_wd + (size_t)layer * K * N; dst = P.wt_dn; break;
    }
}
HD void st_wconv(const Params& P, const Dims& d, int layer, int kind, long gid, long nth) {
    const float* W; int K, N; act_t* dst; w_src(P, d, kind, layer, W, K, N, dst);
    const long total = (long)K * N;
    for (long i = gid; i < total; i += nth) { const int k = (int)(i / N), j = (int)(i % N); stf(dst + (size_t)w_dstrow(d, kind, j) * K + k, W[i]); }
}
HD void st_wpad_even(const Params& P, const Dims& d, int, long gid, long nth) {
    const int r0 = d.PA + 4 * d.HS; const long total = (long)(d.NPE - r0) * d.D;
    for (long i = gid; i < total; i += nth) stf(P.wt_in + (size_t)r0 * d.D + i, 0.f);
}

HD void st_norm(const Params& P, const Dims& d, int layer, int which  , int nrows, long gid, long nth) {
    const float* g = (which ? P.norm_ffn_g : P.norm_mix_g) + (size_t)layer * d.D;
    for (long row = gid; row < nrows; row += nth) {
        const RowInfo ri = row_info(d, (int)row); const int b9 = ri.lat ? ri.b : d.B;
        const float* mv = P.modv + ((size_t)layer * (d.B + 1) + b9) * 6 * d.D;
        const float* shift = mv + (which ? 3 : 0) * d.D; const float* scale = mv + (which ? 4 : 1) * d.D;
        const float* hr = P.h + (size_t)row * d.D; float ss = 0.f;
        for (int k = 0; k < d.D; ++k) ss += hr[k] * hr[k];
        const float r = 1.0f / sqrtf(ss / (float)d.D + 1e-6f);
        for (int k = 0; k < d.D; ++k) stf(P.u + (size_t)row * d.D + k, hr[k] * r * g[k] * (1.0f + scale[k]) + shift[k]);
    }
}
HD void st_final_norm(const Params& P, const Dims& d, int, long gid, long nth) {
    for (long row = gid; row < d.ML; row += nth) {
        const float* hr = P.h + (size_t)row * d.D; float ss = 0.f;
        for (int k = 0; k < d.D; ++k) ss += hr[k] * hr[k];
        const float r = 1.0f / sqrtf(ss / (float)d.D + 1e-6f);
        for (int k = 0; k < d.D; ++k) P.out[(size_t)row * d.D + k] = hr[k] * r * P.final_g[k];
    }
}

HD void st_e_conv(const Params& P, const Dims& d, int layer, long gid, long nth) {
    const int C3 = 3 * d.HS * 128; const long total = (long)d.M * C3; const float* cw = P.gdn_conv_w + (size_t)(layer / 2) * 3 * C3;
    for (long i = gid; i < total; i += nth) {
        const int row = (int)(i / C3), ch = (int)(i % C3); const RowInfo ri = row_info(d, row);
        const act_t* p = P.proj + (size_t)row * d.NPE + ch;
        const float x0 = ldf(p), xm = ri.t > 0 ? ldf(p - d.NPE) : 0.f, xp = ri.t < ri.Tn - 1 ? ldf(p + d.NPE) : 0.f;
        P.qkvact[i] = silu_f(xm * cw[ch] + x0 * cw[C3 + ch] + xp * cw[2 * C3 + ch]);
    }
}
HD void st_e_l2(const Params& P, const Dims& d, int, long gid, long nth) {
    const int C3 = 3 * d.HS * 128; const long total = (long)d.M * 2 * d.HS;
    for (long i = gid; i < total; i += nth) {
        const int head = (int)(i % d.HS), which = (int)((i / d.HS) % 2), row = (int)(i / (2 * d.HS));
        float* p = P.qkvact + (size_t)row * C3 + which * d.HS * 128 + head * 128; float ss = 0.f;
        for (int e = 0; e < 128; ++e) ss += p[e] * p[e];
        const float r = 1.0f / sqrtf(ss + 1e-6f);
        for (int e = 0; e < 128; ++e) p[e] *= r;
    }
}
HD void st_e_gb(const Params& P, const Dims& d, int layer, long gid, long nth) {
    const long total = (long)d.M * 2 * d.HS; const int i2 = layer / 2;
    for (long i = gid; i < total; i += nth) {
        const int head = (int)(i % d.HS), dir = (int)((i / d.HS) % 2), row = (int)(i / (2 * d.HS));
        const float a = P.ab[(size_t)row * d.ABW + dir * d.HS + head], b = P.ab[(size_t)row * d.ABW + 2 * d.HS + dir * d.HS + head];
        const int pi = (i2 * 2 + dir) * d.HS + head;
        P.gbuf[i] = -expf(P.gdn_a_log[pi]) * softplus_f(a + P.gdn_dt_bias[pi]);
        P.betabuf[i] = sigmoid_f(b);
    }
}
HD float rope_inv(int i, int n) { return powf(10000.0f, -(float)(2 * i) / (float)n); }
HD void st_e_rope(const Params& P, const Dims& d, int, long gid, long nth) {
    const long total = (long)d.M * 2 * d.HS * 2 * 2 * 16;
    for (long idx = gid; idx < total; idx += nth) {
        long r = idx; const int i = (int)(r % 16); r /= 16; const int half = (int)(r % 2); r /= 2; const int comp = (int)(r % 2); r /= 2;
        const int head = (int)(r % d.HS); r /= d.HS; const int qk = (int)(r % 2); r /= 2; const int row = (int)r;
        const RowInfo ri = row_info(d, row);
        const int off = head * 128 + comp * 64 + half * 32;
        const act_t* src = P.proj + (size_t)row * d.NPE + (qk ? d.PDK : d.PDQ) + off;
        float* dst = (qk ? P.dkr : P.dqr) + (size_t)row * d.HS * 128 + off;
        const float x1 = ldf(src + i), x2 = ldf(src + 16 + i);
        if (ri.lat) { const int pos = half == 0 ? ri.t / 64 : ri.t % 64; const float ang = (float)pos * rope_inv(i, 32); const float cs = cosf(ang), sn = sinf(ang);
            dst[i] = x1 * cs - x2 * sn; dst[16 + i] = x2 * cs + x1 * sn; }
        else { dst[i] = x1; dst[16 + i] = x2; }
    }
}
HD void st_e_gdn(const Params& P, const Dims& d, int, long gid, long nth) {
    const int C3 = 3 * d.HS * 128; const long total = (long)d.B * 2 * d.HS * 128; const float scale = 0.08838834764831845f;
    for (long idx = gid; idx < total; idx += nth) {
        const int e = (int)(idx % 128), head = (int)((idx / 128) % d.HS), dir = (int)((idx / (128 * d.HS)) % 2), b = (int)(idx / (128 * d.HS * 2));
        float s[128];
#pragma unroll
        for (int j = 0; j < 128; ++j) s[j] = 0.f;
        for (int ph = 0; ph < 2; ++ph) {
            const int Tn = ph == 0 ? d.CTX : d.S, base = ph == 0 ? d.ML + b * d.CTX : b * d.S;
            for (int step = 0; step < Tn; ++step) {
                const int row = base + (dir == 0 ? step : Tn - 1 - step);
                const float* q = P.qkvact + (size_t)row * C3 + head * 128; const float* k = q + d.HS * 128; const float ve = q[2 * d.HS * 128 + e];
                const float g = P.gbuf[((size_t)row * 2 + dir) * d.HS + head], beta = P.betabuf[((size_t)row * 2 + dir) * d.HS + head];
                const float dec = expf(g); float kv = 0.f;
#pragma unroll
                for (int j = 0; j < 128; ++j) { s[j] *= dec; kv += k[j] * s[j]; }
                const float vn = beta * (ve - kv); float o = 0.f;
#pragma unroll
                for (int j = 0; j < 128; ++j) { s[j] += k[j] * vn; o += q[j] * s[j]; }
                P.ogdn[(((size_t)dir * d.M + row) * d.HS + head) * 128 + e] = o * scale;
            }
        }
    }
}
struct MS { float m, l; };
HD void ms_init(MS& a) { a.m = -INFINITY; a.l = 0.f; }
HD void ms_add(MS& a, float s) { const float mn = fmaxf(a.m, s); a.l = a.l * expf(a.m - mn) + expf(s - mn); a.m = mn; }
HD void st_e_diff(const Params& P, const Dims& d, int layer, int nrows, long gid, long nth) {
    const int i2 = layer / 2; const long total = (long)nrows * d.HS * 2;
    float s1 = 0.f, s2 = 0.f;
    for (int j = 0; j < 64; ++j) { s1 += P.lq1[i2 * 64 + j] * P.lk1[i2 * 64 + j]; s2 += P.lq2[i2 * 64 + j] * P.lk2[i2 * 64 + j]; }
    const float lam = expf(s1) - expf(s2) + lambda_init_of(layer);
    const int H1 = d.HS * 128;
    for (long idx = gid; idx < total; idx += nth) {
        const int eh = (int)(idx % 2), head = (int)((idx / 2) % d.HS), row = (int)(idx / (2 * d.HS));
        const RowInfo ri = row_info(d, row);
        float q0[64], q1[64], acc[64];
        const float* qp = P.dqr + (size_t)row * H1 + head * 128;
#pragma unroll
        for (int j = 0; j < 64; ++j) { q0[j] = qp[j] * 0.125f; q1[j] = qp[64 + j] * 0.125f; acc[j] = 0.f; }
        MS a0, a1; ms_init(a0); ms_init(a1);
        const int nseg = ri.lat ? 2 : 1;
        for (int pass = 0; pass < 2; ++pass)
            for (int seg = 0; seg < nseg; ++seg) {
                const int kb = (ri.lat && seg == 0) ? ri.b * d.S : d.ML + ri.b * d.CTX, kn = (ri.lat && seg == 0) ? d.S : d.CTX;
                for (int j = 0; j < kn; ++j) {
                    const float* kp = P.dkr + (size_t)(kb + j) * H1 + head * 128; float t0 = 0.f, t1 = 0.f;
#pragma unroll
                    for (int c = 0; c < 64; ++c) { t0 += q0[c] * kp[c]; t1 += q1[c] * kp[64 + c]; }
                    if (pass == 0) { ms_add(a0, t0); ms_add(a1, t1); }
                    else { const float a = expf(t0 - a0.m) / a0.l - lam * expf(t1 - a1.m) / a1.l;
                        const act_t* vp = P.proj + (size_t)(kb + j) * d.NPE + d.PDV + head * 128 + eh * 64;
#pragma unroll
                        for (int c = 0; c < 64; ++c) acc[c] += a * ldf(vp + c); }
                }
            }
        float* op = P.odiff + (size_t)row * H1 + head * 128 + eh * 64;
#pragma unroll
        for (int c = 0; c < 64; ++c) op[c] = acc[c];
    }
}
HD void st_e_merge(const Params& P, const Dims& d, int layer, int nrows, long gid, long nth) {
    const int i2 = layer / 2, H1 = d.HS * 128; const long total = (long)nrows * 2 * d.HS; const float li = lambda_init_of(layer);
    for (long idx = gid; idx < total; idx += nth) {
        const int hs = (int)(idx % (2 * d.HS)), row = (int)(idx / (2 * d.HS));
        if (hs < d.HS) {
            const float* o0 = P.ogdn + ((size_t)row * d.HS + hs) * 128; const float* o1 = o0 + (size_t)d.M * H1; float ss = 0.f;
            for (int e = 0; e < 128; ++e) { const float o = o0[e] + o1[e]; ss += o * o; }
            const float r = 1.0f / sqrtf(ss / 128.f + 1e-6f);
            for (int e = 0; e < 128; ++e) { const float z = ldf(P.proj + (size_t)row * d.NPE + d.PZ + hs * 128 + e);
                stf(P.y + (size_t)row * d.D + hs * 128 + e, (o0[e] + o1[e]) * r * P.gdn_norm_g[i2 * 128 + e] * silu_f(z)); }
        } else {
            const int hh = hs - d.HS; const float* o = P.odiff + (size_t)row * H1 + hh * 128; float ss = 0.f;
            for (int e = 0; e < 128; ++e) ss += o[e] * o[e];
            const float r = 1.0f / sqrtf(ss / 128.f + 1e-6f);
            for (int e = 0; e < 128; ++e) stf(P.y + (size_t)row * d.D + H1 + hh * 128 + e, o[e] * r * P.subln_g[i2 * 128 + e] * (1.0f - li));
        }
    }
}

HD void st_o_rope(const Params& P, const Dims& d, int, long gid, long nth) {
    const int NS = d.HS + 2; const long total = (long)d.M * NS * 2 * 32;
    for (long idx = gid; idx < total; idx += nth) {
        long r = idx; const int i = (int)(r % 32); r /= 32; const int half = (int)(r % 2); r /= 2; const int slot = (int)(r % NS); r /= NS; const int row = (int)r;
        const RowInfo ri = row_info(d, row);
        const act_t* src = P.proj + (size_t)row * d.NPO + (slot < d.HS ? d.PWQ + slot * 128 : d.PWK + (slot - d.HS) * 128) + half * 64;
        float* dst = (slot < d.HS ? P.wqr + ((size_t)row * d.HS + slot) * 128 : P.wkr + ((size_t)row * 2 + (slot - d.HS)) * 128) + half * 64;
        const float x1 = ldf(src + i), x2 = ldf(src + 32 + i);
        if (ri.lat) { const int pos = half == 0 ? ri.t / 64 : ri.t % 64; const float ang = (float)pos * rope_inv(i, 64); const float cs = cosf(ang), sn = sinf(ang);
            dst[i] = x1 * cs - x2 * sn; dst[32 + i] = x2 * cs + x1 * sn; }
        else { dst[i] = x1; dst[32 + i] = x2; }
    }
}
HD int clampi(int v, int lo, int hi) { return v < lo ? lo : (v > hi ? hi : v); }
HD void st_o_na(const Params& P, const Dims& d, int layer, int nrows, long gid, long nth) {
    const int i2 = layer / 2; const long total = (long)nrows * d.HS * 2; const float scale = 0.08838834764831845f;
    for (long idx = gid; idx < total; idx += nth) {
        const int eh = (int)(idx % 2), head = (int)((idx / 2) % d.HS), row = (int)(idx / (2 * d.HS));
        const RowInfo ri = row_info(d, row);
        float q[128], acc[64];
        const act_t* qp = P.proj + (size_t)row * d.NPO + d.PNQ + head * 128;
#pragma unroll
        for (int j = 0; j < 128; ++j) q[j] = ldf(qp + j) * scale;
#pragma unroll
        for (int j = 0; j < 64; ++j) acc[j] = 0.f;
        const int r = ri.t / 64, c = ri.t % 64;
        const int kr = d.GR < 8 ? d.GR : 8;
        const int r0 = clampi(r - kr / 2, 0, d.GR - kr), c0 = clampi(c - 8, 0, 64 - 16);
        const float* rpb = P.na_rpb + ((size_t)i2 * d.HS + head) * 15 * 31;
        const int nloc = ri.lat ? kr * 16 : 0;
        MS a; ms_init(a);
        for (int pass = 0; pass < 2; ++pass)
            for (int j = 0; j < nloc + d.CTX; ++j) {
                int krow; float bias = 0.f;
                if (j < nloc) { const int rr = r0 + j / 16, cc = c0 + j % 16; krow = ri.b * d.S + rr * 64 + cc; bias = rpb[(rr - r + 7) * 31 + (cc - c + 15)]; }
                else krow = d.ML + ri.b * d.CTX + (j - nloc);
                const act_t* kp = P.proj + (size_t)krow * d.NPO + d.PNK + head * 128; float t = 0.f;
#pragma unroll
                for (int e = 0; e < 128; ++e) t += q[e] * ldf(kp + e);
                t += bias;
                if (pass == 0) ms_add(a, t);
                else { const float p = expf(t - a.m) / a.l; const act_t* vp = P.proj + (size_t)krow * d.NPO + d.PNV + head * 128 + eh * 64;
#pragma unroll
                    for (int e = 0; e < 64; ++e) acc[e] += p * ldf(vp + e); }
            }
        act_t* op = P.y + (size_t)row * d.D + head * 128 + eh * 64;
#pragma unroll
        for (int e = 0; e < 64; ++e) stf(op + e, acc[e]);
    }
}
HD void st_o_win(const Params& P, const Dims& d, int layer, int nrows, long gid, long nth) {
    const int i2 = layer / 2; const long total = (long)nrows * d.HS * 2; const float scale = 0.08838834764831845f; const int grp = d.HS / 2;
    for (long idx = gid; idx < total; idx += nth) {
        const int eh = (int)(idx % 2), head = (int)((idx / 2) % d.HS), row = (int)(idx / (2 * d.HS));
        const RowInfo ri = row_info(d, row); const int kvh = head / grp;
        float q[128], acc[64];
        const float* qp = P.wqr + ((size_t)row * d.HS + head) * 128;
#pragma unroll
        for (int j = 0; j < 128; ++j) q[j] = qp[j] * scale;
#pragma unroll
        for (int j = 0; j < 64; ++j) acc[j] = 0.f;
        const int lo = ri.lat ? (ri.t - 128 < 0 ? 0 : ri.t - 128) : 0, hi = ri.lat ? (ri.t + 128 > d.S - 1 ? d.S - 1 : ri.t + 128) : -1;
        const int nloc = hi - lo + 1;
        const float sink = P.win_sink[i2 * d.HS + head];
        MS a; ms_init(a);
        for (int pass = 0; pass < 2; ++pass) {
            for (int j = 0; j < nloc + d.CTX; ++j) {
                const int krow = j < nloc ? ri.b * d.S + lo + j : d.ML + ri.b * d.CTX + (j - nloc);
                const float* kp = P.wkr + ((size_t)krow * 2 + kvh) * 128; float t = 0.f;
#pragma unroll
                for (int e = 0; e < 128; ++e) t += q[e] * kp[e];
                if (pass == 0) ms_add(a, t);
                else { const float p = expf(t - a.m) / a.l; const act_t* vp = P.proj + (size_t)krow * d.NPO + d.PWV + kvh * 128 + eh * 64;
#pragma unroll
                    for (int e = 0; e < 64; ++e) acc[e] += p * ldf(vp + e); }
            }
            if (pass == 0) ms_add(a, sink);
        }
        act_t* op = P.y + (size_t)row * d.D + d.HS * 128 + head * 128 + eh * 64;
#pragma unroll
        for (int e = 0; e < 64; ++e) stf(op + e, acc[e]);
    }
}

HD const float* gate_vec(const Params& P, const Dims& d, int layer, int row, int chunk) {
    const RowInfo ri = row_info(d, row); const int b9 = ri.lat ? ri.b : d.B;
    return P.modv + ((size_t)layer * (d.B + 1) + b9) * 6 * d.D + (size_t)chunk * d.D;
}

#ifndef HOST_TEST
namespace pg8 {
#define PG8_LAS __attribute__((address_space(3)))
typedef unsigned short bf16_t;
typedef short bf16x8 __attribute__((ext_vector_type(8)));
typedef float f32x4 __attribute__((ext_vector_type(4)));
typedef unsigned u32x4 __attribute__((ext_vector_type(4)));
constexpr int BM = 256, BK = 64, HALF = 128, HTB = HALF * BK * 2  , STAGE_BYTES = 8 * HTB, NXCD = 8, WGM = 8;

__host__ __device__ __forceinline__ int lds_byte(int r, int c) { const int st = (r >> 4) * 2 + (c >> 5), rr = r & 15, cc = c & 31, ob = rr * 64 + cc * 2; return st * 1024 + (ob ^ (((ob >> 9) & 1) << 5)); }
__host__ __device__ __forceinline__ void stage_rc(int b, int& R, int& C) { const int st = b / 1024, sb = b % 1024, swz = sb ^ (((sb >> 9) & 1) << 5); R = (st >> 1) * 16 + swz / 64; C = (st & 1) * 32 + (swz % 64) / 2; }
__host__ __device__ __forceinline__ int perm32(int rho) { const int n = rho >> 4, i = rho & 15; return 8 * (i >> 2) + 4 * n + (i & 3); }

struct Unit { int pm, pn; };
struct Gemm { const bf16_t* A; const bf16_t* Bt; int M, N, K; };

struct StaticOrder {
    int nM, nN, nwg, G, c;
    __host__ __device__ void init(int M, int N, int G_, int c_) { nM = M / BM; nN = N / BM; nwg = nM * nN; G = G_; c = c_; }
    __host__ __device__ bool next(int i, Unit& u) const {
        const long L = (long)i * G + c; if (L >= nwg) return false;
        int wgid = (int)L; { const int q = nwg / NXCD, r = nwg % NXCD, xcd = wgid % NXCD, off = wgid / NXCD; wgid = (xcd < r ? xcd * (q + 1) : r * (q + 1) + (xcd - r) * q) + off; }
        const int nig = WGM * nN, gid = wgid / nig, fm = gid * WGM, gsz = (nM - fm) < WGM ? (nM - fm) : WGM;
        u.pm = fm + ((wgid % nig) % gsz); u.pn = (wgid % nig) / gsz; return true;
    }
    __device__ __forceinline__ void a_ready(const Unit&) const {}
    __device__ __forceinline__ void done(const Unit&) const {}
};
__device__ __forceinline__ unsigned cvt_pk_bf16(float lo, float hi) { unsigned r; asm volatile("v_cvt_pk_bf16_f32 %0, %1, %2" : "=v"(r) : "v"(lo), "v"(hi)); return r; }
struct EpiProj {
    static constexpr bool PERM = true, AFTER_DRAIN = false;
    bf16_t* O; int ldc; float* ab; int abw; int ab_tile;
    __device__ __forceinline__ void operator()(const f32x4 (&acc)[2][2][4][2], const Unit& u, int wr, int wc, int fr, int fq) const {
        const int row0 = u.pm * BM + wr * 64 + fr;
        if (u.pn == ab_tile) {
            if (wc == 0) {
#pragma unroll
                for (int ai = 0; ai < 2; ++ai)
#pragma unroll
                    for (int m = 0; m < 4; ++m) { float* p = ab + (size_t)(row0 + ai * HALF + m * 16) * abw + 8 * fq;
                        *(f32x4*)p = acc[ai][0][m][0]; *(f32x4*)(p + 4) = acc[ai][0][m][1]; }
            }
            return;
        }
        const int col0 = u.pn * BM + wc * 32 + 8 * fq;
#pragma unroll
        for (int ai = 0; ai < 2; ++ai)
#pragma unroll
            for (int m = 0; m < 4; ++m) { bf16_t* rowp = O + (size_t)(row0 + ai * HALF + m * 16) * ldc + col0;
#pragma unroll
                for (int bj = 0; bj < 2; ++bj) { const f32x4 v0 = acc[ai][bj][m][0], v1 = acc[ai][bj][m][1];
                    u32x4 w; w.x = cvt_pk_bf16(v0[0], v0[1]); w.y = cvt_pk_bf16(v0[2], v0[3]); w.z = cvt_pk_bf16(v1[0], v1[1]); w.w = cvt_pk_bf16(v1[2], v1[3]);
                    *(u32x4*)(rowp + bj * HALF) = w; } }
    }
};
struct EpiResid {
    static constexpr bool PERM = false, AFTER_DRAIN = false;
    float* H; int ldc; const float* gate0; int S, ML, B, D6;
    __device__ __forceinline__ void operator()(const f32x4 (&acc)[2][2][4][2], const Unit& u, int wr, int wc, int fr, int fq) const {
        const int r0t = u.pm * BM; const int b9 = r0t < ML ? r0t / S : B;
        const float* gate = gate0 + (size_t)b9 * D6;
        const int row0 = r0t + wr * 64 + fr, col0 = u.pn * BM + wc * 32 + 4 * fq;
        f32x4 gv[2][2];
#pragma unroll
        for (int bj = 0; bj < 2; ++bj)
#pragma unroll
            for (int n = 0; n < 2; ++n) gv[bj][n] = *(const f32x4*)(gate + col0 + bj * HALF + n * 16);
#pragma unroll
        for (int ai = 0; ai < 2; ++ai)
#pragma unroll
            for (int m = 0; m < 4; ++m) { float* rowp = H + (size_t)(row0 + ai * HALF + m * 16) * ldc + col0;
#pragma unroll
                for (int bj = 0; bj < 2; ++bj)
#pragma unroll
                    for (int n = 0; n < 2; ++n) { f32x4* p = (f32x4*)(rowp + bj * HALF + n * 16); *p = *p + gv[bj][n] * acc[ai][bj][m][n]; } }
    }
};
struct EpiSwiGLU {
    static constexpr bool PERM = true, AFTER_DRAIN = false;
    bf16_t* O; int ldc;
    __device__ __forceinline__ void operator()(const f32x4 (&acc)[2][2][4][2], const Unit& u, int wr, int wc, int fr, int fq) const {
        const int row0 = u.pm * BM + wr * 64 + fr, col0 = u.pn * HALF + wc * 32 + 8 * fq;
#pragma unroll
        for (int ai = 0; ai < 2; ++ai)
#pragma unroll
            for (int m = 0; m < 4; ++m) { float o[8];
#pragma unroll
                for (int n = 0; n < 2; ++n)
#pragma unroll
                    for (int j = 0; j < 4; ++j) { const float g = acc[ai][0][m][n][j], up = acc[ai][1][m][n][j]; o[n * 4 + j] = g * __builtin_amdgcn_rcpf(1.0f + __expf(-g)) * up; }
                u32x4 w; w.x = cvt_pk_bf16(o[0], o[1]); w.y = cvt_pk_bf16(o[2], o[3]); w.z = cvt_pk_bf16(o[4], o[5]); w.w = cvt_pk_bf16(o[6], o[7]);
                *(u32x4*)(O + (size_t)(row0 + ai * HALF + m * 16) * ldc + col0) = w; }
    }
};
template <class Epi, class Sched, bool ALIGN_EPI = false, bool SP2 = false>
__device__ __forceinline__ void gemm_phase(PG8_LAS unsigned char* lds, const Gemm g, const Sched& S, const Epi& E) {
    const int tid = threadIdx.x, wid = __builtin_amdgcn_readfirstlane(tid >> 6), lane = tid & 63, wr = wid >> 2, wc = wid & 3, fr = lane & 15, fq = lane >> 4;
    const int K = g.K, nt = K / BK;
    unsigned voffA[2], voffB[2];
#pragma unroll
    for (int i = 0; i < 2; ++i) { int R, C; stage_rc(tid * 16 + i * 8192, R, C); const int Rb = Epi::PERM ? ((R & ~31) + perm32(R & 31)) : R;
        voffA[i] = (unsigned)(R * K + C) * 2u; voffB[i] = (unsigned)(Rb * K + C) * 2u; }
    const size_t kstep = (size_t)(BK * 2);
    const size_t hstep = (size_t)HALF * K * 2;
    const size_t tstep = 2 * hstep;
    const unsigned ldsw = (unsigned)wid * 1024u;
    const int aoff = lds_byte(wr * 64 + fr, fq * 8), boff = lds_byte(wc * 32 + fr, fq * 8);
#define PG8_SA(b, h) (((b) * 2 + (h)) * HTB)
#define PG8_SB(b, h) ((4 + (b) * 2 + (h)) * HTB)
#define PG8_STAGE(bufoff, gbase, voff) do { _Pragma("unroll") for (int _i = 0; _i < 2; ++_i) \
        __builtin_amdgcn_global_load_lds((const unsigned*)((const char*)(gbase) + (voff)[_i]), (PG8_LAS unsigned*)(lds + (bufoff) + ldsw + _i * 8192), 16, 0, 0); } while (0)
#define PG8_LDA(dst, b, h) do { _Pragma("unroll") for (int m = 0; m < 4; ++m) _Pragma("unroll") for (int k = 0; k < 2; ++k) dst[m][k] = *(const PG8_LAS bf16x8*)(lds + PG8_SA(b, h) + aoff + m * 2048 + k * 1024); } while (0)
#define PG8_LDB(dst, b, h) do { _Pragma("unroll") for (int n = 0; n < 2; ++n) _Pragma("unroll") for (int k = 0; k < 2; ++k) dst[n][k] = *(const PG8_LAS bf16x8*)(lds + PG8_SB(b, h) + boff + n * 2048 + k * 1024); } while (0)
#define PG8_MMA(ai, bj, At, Bt) do { __builtin_amdgcn_s_setprio(1); _Pragma("unroll") for (int m = 0; m < 4; ++m) _Pragma("unroll") for (int n = 0; n < 2; ++n) _Pragma("unroll") for (int k = 0; k < 2; ++k) \
        acc[ai][bj][m][n] = __builtin_amdgcn_mfma_f32_16x16x32_bf16(Bt[n][k], At[m][k], acc[ai][bj][m][n], 0, 0, 0); __builtin_amdgcn_s_setprio(0); } while (0)
#define PG8_WAIT_V(n) asm volatile("s_waitcnt vmcnt(" #n ")" ::: "memory")
#define PG8_WAIT_L(n) asm volatile("s_waitcnt lgkmcnt(" #n ")" ::: "memory")
#define PG8_BAR __builtin_amdgcn_s_barrier()
#define PG8_SCHED __builtin_amdgcn_sched_barrier(0)
    Unit cur, nxt; int ui = 0;
    if (!S.next(0, cur)) return;
    f32x4 acc[2][2][4][2];
#pragma unroll
    for (int a = 0; a < 2; ++a)
#pragma unroll
        for (int b = 0; b < 2; ++b)
#pragma unroll
            for (int m = 0; m < 4; ++m)
#pragma unroll
                for (int n = 0; n < 2; ++n) acc[a][b][m][n] = (f32x4){0.f, 0.f, 0.f, 0.f};
    bf16x8 At[4][2], B0[2][2], B1[2][2];
    const char* cA = (const char*)g.A + (size_t)cur.pm * tstep; const char* cB = (const char*)g.Bt + (size_t)cur.pn * tstep;
    S.a_ready(cur);
    if constexpr (SP2) {
        PG8_STAGE(PG8_SB(0, 0), cB, voffB); PG8_STAGE(PG8_SB(0, 1), cB + hstep, voffB); PG8_STAGE(PG8_SA(0, 0), cA, voffA); PG8_STAGE(PG8_SA(0, 1), cA + hstep, voffA);
        if (wr == 1) PG8_BAR;
        PG8_WAIT_V(2); PG8_BAR;
        PG8_STAGE(PG8_SB(1, 0), cB + kstep, voffB); PG8_STAGE(PG8_SA(1, 0), cA + kstep, voffA); PG8_STAGE(PG8_SB(1, 1), cB + hstep + kstep, voffB);
        PG8_WAIT_V(6); PG8_BAR;
    } else {
        PG8_STAGE(PG8_SB(0, 0), cB, voffB); PG8_STAGE(PG8_SA(0, 0), cA, voffA); PG8_STAGE(PG8_SB(0, 1), cB + hstep, voffB); PG8_STAGE(PG8_SA(0, 1), cA + hstep, voffA);
        if (wr == 1) PG8_BAR;
        PG8_WAIT_V(4); PG8_BAR;
        PG8_STAGE(PG8_SB(1, 0), cB + kstep, voffB); PG8_STAGE(PG8_SA(1, 0), cA + kstep, voffA); PG8_STAGE(PG8_SB(1, 1), cB + hstep + kstep, voffB);
        PG8_WAIT_V(6); PG8_BAR;
    }
    for (;;) {
        const bool has_next = S.next(ui + 1, nxt);
        const char* nA = has_next ? (const char*)g.A + (size_t)nxt.pm * tstep : cA; const char* nB = has_next ? (const char*)g.Bt + (size_t)nxt.pn * tstep : cB;
        for (int t = 0; t < nt; t += 2) {
            const bool last = (t == nt - 2);
            const char* a1 = cA + (size_t)(t + 1) * kstep;
            const char* a2 = last ? nA : cA + (size_t)(t + 2) * kstep; const char* b2 = last ? nB : cB + (size_t)(t + 2) * kstep;
            const char* a3 = a2 + kstep; const char* b3 = b2 + kstep;
            if (last && has_next) S.a_ready(nxt);
            if constexpr (SP2) {
            PG8_LDB(B0, 0, 0); PG8_LDB(B1, 0, 1); PG8_SCHED; PG8_LDA(At, 0, 0); PG8_STAGE(PG8_SA(1, 1), a1 + hstep, voffA);
            PG8_WAIT_V(8); PG8_WAIT_L(0); PG8_BAR; PG8_MMA(0, 0, At, B0); PG8_MMA(0, 1, At, B1); PG8_BAR; PG8_SCHED;
            PG8_LDA(At, 0, 1); PG8_STAGE(PG8_SB(0, 0), b2, voffB); PG8_STAGE(PG8_SB(0, 1), b2 + hstep, voffB); PG8_STAGE(PG8_SA(0, 0), a2, voffA);
            PG8_WAIT_V(8); PG8_WAIT_L(0); PG8_BAR; PG8_MMA(1, 0, At, B0); PG8_MMA(1, 1, At, B1); PG8_BAR; PG8_SCHED;
            PG8_LDB(B0, 1, 0); PG8_LDB(B1, 1, 1); PG8_SCHED; PG8_LDA(At, 1, 0); PG8_STAGE(PG8_SA(0, 1), a2 + hstep, voffA);
            PG8_WAIT_V(8); PG8_WAIT_L(0); PG8_BAR; PG8_MMA(0, 0, At, B0); PG8_MMA(0, 1, At, B1); PG8_BAR; PG8_SCHED;
            PG8_LDA(At, 1, 1); PG8_STAGE(PG8_SB(1, 0), b3, voffB); PG8_STAGE(PG8_SB(1, 1), b3 + hstep, voffB); PG8_STAGE(PG8_SA(1, 0), a3, voffA);
            PG8_WAIT_V(8); PG8_WAIT_L(0); PG8_BAR; PG8_MMA(1, 0, At, B0); PG8_MMA(1, 1, At, B1); PG8_BAR; PG8_SCHED;
            } else {
            PG8_LDB(B0, 0, 0); PG8_SCHED; PG8_LDA(At, 0, 0); PG8_STAGE(PG8_SA(1, 1), a1 + hstep, voffA);
            PG8_WAIT_L(8); PG8_BAR; PG8_WAIT_L(0); PG8_MMA(0, 0, At, B0); PG8_BAR; PG8_SCHED;
            PG8_LDB(B1, 0, 1); PG8_STAGE(PG8_SB(0, 0), b2, voffB);
            PG8_BAR; PG8_WAIT_L(0); PG8_MMA(0, 1, At, B1); PG8_BAR;
            PG8_LDA(At, 0, 1); PG8_STAGE(PG8_SA(0, 0), a2, voffA);
            PG8_BAR; PG8_WAIT_L(0); PG8_MMA(1, 0, At, B0); PG8_BAR; PG8_SCHED;
            PG8_STAGE(PG8_SB(0, 1), b2 + hstep, voffB);
            PG8_WAIT_V(6); PG8_BAR; PG8_MMA(1, 1, At, B1); PG8_BAR;
            PG8_LDB(B0, 1, 0); PG8_SCHED; PG8_LDA(At, 1, 0); PG8_STAGE(PG8_SA(0, 1), a2 + hstep, voffA);
            PG8_WAIT_L(8); PG8_BAR; PG8_WAIT_L(0); PG8_MMA(0, 0, At, B0); PG8_BAR; PG8_SCHED;
            PG8_LDB(B1, 1, 1); PG8_STAGE(PG8_SB(1, 0), b3, voffB);
            PG8_BAR; PG8_WAIT_L(0); PG8_MMA(0, 1, At, B1); PG8_BAR;
            PG8_LDA(At, 1, 1); PG8_STAGE(PG8_SA(1, 0), a3, voffA);
            PG8_BAR; PG8_WAIT_L(0); PG8_MMA(1, 0, At, B0); PG8_BAR; PG8_SCHED;
            PG8_STAGE(PG8_SB(1, 1), b3 + hstep, voffB);
            PG8_WAIT_V(6); PG8_BAR; PG8_MMA(1, 1, At, B1); PG8_BAR;
            }
        }
        if constexpr (ALIGN_EPI) { if (wr == 0) PG8_BAR; }
        if constexpr (!Epi::AFTER_DRAIN) { E(acc, cur, wr, wc, fr, fq); S.done(cur); }
        if (!has_next) break;
#pragma unroll
        for (int a = 0; a < 2; ++a)
#pragma unroll
            for (int b = 0; b < 2; ++b)
#pragma unroll
                for (int m = 0; m < 4; ++m)
#pragma unroll
                    for (int n = 0; n < 2; ++n) acc[a][b][m][n] = (f32x4){0.f, 0.f, 0.f, 0.f};
        cur = nxt; cA = nA; cB = nB; ++ui;
        if constexpr (ALIGN_EPI) { if (wr == 1) PG8_BAR; }
    }
    PG8_WAIT_V(0);
    if constexpr (!ALIGN_EPI) { if (wr == 0) PG8_BAR; }
    PG8_BAR;
    if constexpr (Epi::AFTER_DRAIN) { E.fused(acc, cur, wr, wc, fr, fq, lds, wid, lane); S.done(cur); }
#undef PG8_SA
#undef PG8_SB
#undef PG8_STAGE
#undef PG8_LDA
#undef PG8_LDB
#undef PG8_MMA
#undef PG8_WAIT_V
#undef PG8_WAIT_L
#undef PG8_BAR
#undef PG8_SCHED
}
}

#define LAS __attribute__((address_space(3)))
typedef unsigned v4u __attribute__((ext_vector_type(4)));
typedef float f32x4 __attribute__((ext_vector_type(4)));
__device__ __forceinline__ unsigned pk2(float lo, float hi) { return (unsigned)f2bf(lo) | ((unsigned)f2bf(hi) << 16); }
__device__ __forceinline__ float wave_sum(float v) {
#pragma unroll
    for (int o = 1; o < 64; o <<= 1) v += __shfl_xor(v, o);
    return v;
}

enum StageId { SG_MOD, SG_COPYH, SG_WPAD, SG_ECONV, SG_EL2, SG_EGB, SG_EROPE, SG_EGDN, SG_EDIFF, SG_EMERGE, SG_OROPE, SG_ONA, SG_OWIN };
template <int SG> __global__ void __launch_bounds__(256) k_stage(Params P, Dims d, int layer, int nrows) {
    const long gid = (long)blockIdx.x * 256 + threadIdx.x, nth = (long)gridDim.x * 256;
    if constexpr (SG == SG_MOD) st_mod(P, d, layer, gid, nth);
    if constexpr (SG == SG_COPYH) st_copy_h(P, d, layer, gid, nth);
    if constexpr (SG == SG_WPAD) st_wpad_even(P, d, layer, gid, nth);
    if constexpr (SG == SG_ECONV) st_e_conv(P, d, layer, gid, nth);
    if constexpr (SG == SG_EL2) st_e_l2(P, d, layer, gid, nth);
    if constexpr (SG == SG_EGB) st_e_gb(P, d, layer, gid, nth);
    if constexpr (SG == SG_EROPE) st_e_rope(P, d, layer, gid, nth);
    if constexpr (SG == SG_EGDN) st_e_gdn(P, d, layer, gid, nth);
    if constexpr (SG == SG_EDIFF) st_e_diff(P, d, layer, nrows, gid, nth);
    if constexpr (SG == SG_EMERGE) st_e_merge(P, d, layer, nrows, gid, nth);
    if constexpr (SG == SG_OROPE) st_o_rope(P, d, layer, gid, nth);
    if constexpr (SG == SG_ONA) st_o_na(P, d, layer, nrows, gid, nth);
    if constexpr (SG == SG_OWIN) st_o_win(P, d, layer, nrows, gid, nth);
}

__global__ void __launch_bounds__(256) k_wconv(const float* W, act_t* dst, int K, int N, Dims d, int kind) {
    __shared__ float scr_all[4][64 * 33];
    const int lane = threadIdx.x & 63, wave = threadIdx.x >> 6;
    LAS float* scr = (LAS float*)&scr_all[wave][0];
    const int nblk = N / 32, nitems = (K / 64) * nblk;
    for (int item = blockIdx.x * 4 + wave; item < nitems; item += gridDim.x * 4) {
        const int kb = item / nblk, nb = item % nblk, k0 = 64 * kb, n0 = 32 * nb;
#pragma unroll 8
        for (int i = 0; i < 32; ++i) { const int kk = 2 * i + (lane >> 5); scr[kk * 33 + (lane & 31)] = W[(size_t)(k0 + kk) * N + n0 + (lane & 31)]; }
        asm volatile("s_waitcnt lgkmcnt(0)" ::: "memory");
        const int c = lane & 7;
#pragma unroll
        for (int j = 0; j < 4; ++j) { const int n = (lane >> 3) + 8 * j; const LAS float* s = scr + (8 * c) * 33 + n;
            v4u o; o.x = pk2(s[0 * 33], s[1 * 33]); o.y = pk2(s[2 * 33], s[3 * 33]); o.z = pk2(s[4 * 33], s[5 * 33]); o.w = pk2(s[6 * 33], s[7 * 33]);
            *(v4u*)(dst + (size_t)w_dstrow(d, kind, n0 + n) * K + k0 + 8 * c) = o; }
        asm volatile("s_waitcnt lgkmcnt(0)" ::: "memory");
    }
}

__global__ void __launch_bounds__(256) k_norm(Params P, Dims d, int layer, int which, int nrows) {
    const int lane = threadIdx.x & 63; const int gw = blockIdx.x * 4 + (threadIdx.x >> 6), ngw = gridDim.x * 4;
    const int NV = d.D / 256;
    for (int row = gw; row < nrows; row += ngw) {
        const f32x4* hr = (const f32x4*)(P.h + (size_t)row * d.D) + lane;
        f32x4 v[8]; float ss = 0.f;
#pragma unroll
        for (int j = 0; j < 8; ++j) if (j < NV) { v[j] = hr[64 * j]; ss += (v[j].x * v[j].x + v[j].y * v[j].y) + (v[j].z * v[j].z + v[j].w * v[j].w); }
        const float r = 1.0f / sqrtf(wave_sum(ss) / (float)d.D + 1e-6f);
        if (which == 2) {
            f32x4* o = (f32x4*)(P.out + (size_t)row * d.D) + lane; const f32x4* g = (const f32x4*)P.final_g + lane;
#pragma unroll
            for (int j = 0; j < 8; ++j) if (j < NV) o[64 * j] = v[j] * r * g[64 * j];
        } else {
            const int b9 = row < d.ML ? row / d.S : d.B;
            const float* mv = P.modv + ((size_t)layer * (d.B + 1) + b9) * 6 * d.D;
            const f32x4* g = (const f32x4*)((which ? P.norm_ffn_g : P.norm_mix_g) + (size_t)layer * d.D) + lane;
            const f32x4* sh = (const f32x4*)(mv + (which ? 3 : 0) * d.D) + lane; const f32x4* sc = (const f32x4*)(mv + (which ? 4 : 1) * d.D) + lane;
            unsigned long long* o8 = (unsigned long long*)(P.u + (size_t)row * d.D) + lane;
#pragma unroll
            for (int j = 0; j < 8; ++j) if (j < NV) { const f32x4 t = v[j] * r * g[64 * j] * (sc[64 * j] + 1.0f) + sh[64 * j];
                o8[64 * j] = (unsigned long long)pk2(t.x, t.y) | ((unsigned long long)pk2(t.z, t.w) << 32); }
        }
    }
}

template <class Epi> __global__ void __launch_bounds__(512, 2) k_gemm(pg8::Gemm g, Epi E) {
    extern __shared__ __attribute__((aligned(16))) unsigned char shm[];
    pg8::StaticOrder S; S.init(g.M, g.N, (int)gridDim.x, (int)blockIdx.x);
    pg8::gemm_phase<Epi, pg8::StaticOrder, true, true>((PG8_LAS unsigned char*)shm, g, S, E);
}
template <class Epi> static void launch_gemm(const pg8::Gemm& g, const Epi& E, hipStream_t st) {
    static bool attr = false; if (!attr) { (void)hipFuncSetAttribute((const void*)k_gemm<Epi>, hipFuncAttributeMaxDynamicSharedMemorySize, pg8::STAGE_BYTES); attr = true; }
    hipLaunchKernelGGL((k_gemm<Epi>), dim3(256), dim3(512), pg8::STAGE_BYTES, st, g, E);
}
template <int SG> static void launch_stage(const Params& P, const Dims& d, int layer, int nrows, long items, hipStream_t st) {
    long blocks = (items + 255) / 256; if (blocks > 65536) blocks = 65536; if (blocks < 1) blocks = 1;
    hipLaunchKernelGGL((k_stage<SG>), dim3((unsigned)blocks), dim3(256), 0, st, P, d, layer, nrows);
}

static pg8::Gemm mk_gemm(const act_t* A, const act_t* Bt, int M, int N, int K) { pg8::Gemm g; memset(&g, 0, sizeof(g)); g.A = A; g.Bt = Bt; g.M = M; g.N = N; g.K = K; return g; }
static pg8::EpiResid mk_resid(float* H, const Dims& d, const float* gate0) { pg8::EpiResid E; memset(&E, 0, sizeof(E)); E.H = H; E.ldc = d.D; E.gate0 = gate0; E.S = d.S; E.ML = d.ML; E.B = d.B; E.D6 = 6 * d.D; return E; }
extern "C" void kernel_launch(void* const* d_in, const int* in_sizes, int n_in, void* d_out, int out_size, void* d_ws, size_t ws_size, hipStream_t stream) {
    Dims d; memset(&d, 0, sizeof(d)); d = make_dims(2048, 8, 2048, 256, 4);
    Params P; memset(&P, 0, sizeof(P));
    const float* const* in = (const float* const*)d_in;
    P.x = in[0]; P.c = in[1]; P.ctx = in[2]; P.c_ctx = in[3]; P.ada_w = in[4]; P.ada_b = in[5]; P.norm_mix_g = in[6]; P.norm_ffn_g = in[7];
    P.w_in_even = in[8]; P.gdn_conv_w = in[9]; P.gdn_a_log = in[10]; P.gdn_dt_bias = in[11]; P.gdn_norm_g = in[12]; P.lq1 = in[13]; P.lk1 = in[14]; P.lq2 = in[15]; P.lk2 = in[16];
    P.subln_g = in[17]; P.w_in_odd = in[18]; P.na_rpb = in[19]; P.win_sink = in[20]; P.w_out = in[21]; P.ffn_wg = in[22]; P.ffn_wu = in[23]; P.ffn_wd = in[24]; P.final_g = in[25];
    P.out = (float*)d_out;
    const size_t MiB = 1u << 20; unsigned char* ws = (unsigned char*)d_ws; size_t off = 0;
    auto take = [&](size_t bytes) { void* p = ws + off; off += (bytes + MiB - 1) / MiB * MiB; return p; };
    const int H1 = d.HS * 128;
    P.ctl = (unsigned*)take(MiB);
    P.modv = (float*)take((size_t)d.DEPTH * (d.B + 1) * 6 * d.D * 4);
    P.wt_in = (act_t*)take((size_t)d.NPE * d.D * 2); P.wt_out = (act_t*)take((size_t)d.D * d.D * 2); P.wt_gu = (act_t*)take((size_t)2 * d.FF * d.D * 2); P.wt_dn = (act_t*)take((size_t)d.D * d.FF * 2);
    P.h = (float*)take((size_t)d.M * d.D * 4); P.u = (act_t*)take((size_t)d.M * d.D * 2); P.y = (act_t*)take((size_t)d.M * d.D * 2);
    P.proj = (act_t*)take((size_t)d.M * d.NPE * 2); P.hid = P.proj;
    P.ab = (float*)take((size_t)d.M * d.ABW * 4);
    P.qkvact = (float*)take((size_t)d.M * 3 * H1 * 4); P.gbuf = (float*)take((size_t)d.M * 2 * d.HS * 4); P.betabuf = (float*)take((size_t)d.M * 2 * d.HS * 4);
    P.dqr = (float*)take((size_t)d.M * H1 * 4); P.dkr = (float*)take((size_t)d.M * H1 * 4); P.ogdn = (float*)take((size_t)2 * d.M * H1 * 4); P.odiff = (float*)take((size_t)d.M * H1 * 4);
    P.wqr = P.dqr; P.wkr = P.dkr;
    if (off > ws_size || n_in != 26) { fprintf(stderr, "kernel_launch: workspace too small (%zu needed, %zu given) or n_in %d != 26\n", off, ws_size, n_in); return; }

    launch_stage<SG_MOD>(P, d, 0, 0, (long)d.DEPTH * (d.B + 1) * 6 * d.D, stream);
    launch_stage<SG_COPYH>(P, d, 0, 0, (long)d.M * d.D / 4, stream);
    for (int l = 0; l < d.DEPTH; ++l) {
        const bool even = (l % 2) == 0, need_ctx = l < d.DEPTH - 1; const int Mr = need_ctx ? d.M : d.ML; const int NP = even ? d.NPE : d.NPO;
        auto wconv = [&](int kind) { const float* W; int K, N; act_t* dst; w_src(P, d, kind, l, W, K, N, dst); hipLaunchKernelGGL(k_wconv, dim3(1024), dim3(256), 0, stream, W, dst, K, N, d, kind); };
        wconv(even ? (int)WK_IN_EVEN : (int)WK_IN_ODD);
        if (even) launch_stage<SG_WPAD>(P, d, l, 0, (long)(d.NPE - d.PA - 4 * d.HS) * d.D, stream);
        wconv((int)WK_OUT);
        wconv((int)WK_GATE);
        wconv((int)WK_UP);
        wconv((int)WK_DOWN);
        hipLaunchKernelGGL(k_norm, dim3(2048), dim3(256), 0, stream, P, d, l, 0, d.M);
        { pg8::Gemm g = mk_gemm(P.u, P.wt_in, d.M, NP, d.D); pg8::EpiProj E; memset(&E, 0, sizeof(E)); E.O = P.proj; E.ldc = NP; E.ab = P.ab; E.abw = d.ABW; E.ab_tile = even ? d.PA / 256 : -1; launch_gemm(g, E, stream); }
        if (even) {
            launch_stage<SG_ECONV>(P, d, l, 0, (long)d.M * 3 * H1, stream);
            launch_stage<SG_EL2>(P, d, l, 0, (long)d.M * 2 * d.HS, stream);
            launch_stage<SG_EGB>(P, d, l, 0, (long)d.M * 2 * d.HS, stream);
            launch_stage<SG_EROPE>(P, d, l, 0, (long)d.M * 2 * d.HS * 2 * 2 * 16, stream);
            launch_stage<SG_EGDN>(P, d, l, 0, (long)d.B * 2 * d.HS * 128, stream);
            launch_stage<SG_EDIFF>(P, d, l, Mr, (long)Mr * d.HS * 2, stream);
            launch_stage<SG_EMERGE>(P, d, l, Mr, (long)Mr * 2 * d.HS, stream);
        } else {
            launch_stage<SG_OROPE>(P, d, l, 0, (long)d.M * (d.HS + 2) * 2 * 32, stream);
            launch_stage<SG_ONA>(P, d, l, Mr, (long)Mr * d.HS * 2, stream);
            launch_stage<SG_OWIN>(P, d, l, Mr, (long)Mr * d.HS * 2, stream);
        }
        const float* modl = P.modv + (size_t)l * (d.B + 1) * 6 * d.D;
        { pg8::Gemm g = mk_gemm(P.y, P.wt_out, Mr, d.D, d.D); pg8::EpiResid E = mk_resid(P.h, d, modl + 2 * d.D); launch_gemm(g, E, stream); }
        hipLaunchKernelGGL(k_norm, dim3(2048), dim3(256), 0, stream, P, d, l, 1, Mr);
        { pg8::Gemm g = mk_gemm(P.u, P.wt_gu, Mr, 2 * d.FF, d.D); pg8::EpiSwiGLU E; memset(&E, 0, sizeof(E)); E.O = P.hid; E.ldc = d.FF; launch_gemm(g, E, stream); }
        { pg8::Gemm g = mk_gemm(P.hid, P.wt_dn, Mr, d.D, d.FF); pg8::EpiResid E = mk_resid(P.h, d, modl + 5 * d.D); launch_gemm(g, E, stream); }
    }
    hipLaunchKernelGGL(k_norm, dim3(2048), dim3(256), 0, stream, P, d, 0, 2, d.ML);
}
#endif
```

```cpp
#include <cstdio>
#include <cstring>
#include <hip/hip_runtime.h>
#include <cmath>
#include <cstdint>

#define HD __host__ __device__ __forceinline__

typedef unsigned short bf16_t;
#ifdef ACT_F32
typedef float act_t;
HD float ldf(const float* p) { return *p; }
HD void stf(float* p, float v) { *p = v; }
#else
typedef bf16_t act_t;
#endif
HD float bf2f(bf16_t v) { return __builtin_bit_cast(float, ((unsigned)v) << 16); }
HD bf16_t f2bf(float f) { unsigned u = __builtin_bit_cast(unsigned, f); return (bf16_t)((u + 0x7fffu + ((u >> 16) & 1u)) >> 16); }
HD float ldf(const bf16_t* p) { return bf2f(*p); }
HD void stf(bf16_t* p, float v) { *p = f2bf(v); }

struct Dims {
    int D, B, S, CTX, FF, HS, DEPTH;
    int ML, MC, M;
    int NPE, NPO;
    int PQ, PK, PV, PZ, PDQ, PDK, PDV, PA, PB;
    int PNQ, PNK, PNV, PWQ, PWK, PWV;
    int ABW;
    int GR;
    int rope_perm;
};
HD constexpr Dims make_dims(int D, int B, int S, int CTX, int DEPTH) {
    Dims d{}; d.D = D; d.B = B; d.S = S; d.CTX = CTX; d.DEPTH = DEPTH; d.HS = D / 256;
    d.FF = ((8 * D + 3 * 256 - 1) / (3 * 256)) * 256;
    d.ML = B * S; d.MC = B * CTX; d.M = d.ML + d.MC;
    const int H1 = d.HS * 128;
    d.PQ = 0; d.PK = H1; d.PV = 2 * H1; d.PZ = 3 * H1; d.PDQ = 4 * H1; d.PDK = 5 * H1; d.PDV = 6 * H1; d.PA = 7 * H1; d.PB = 7 * H1 + 2 * d.HS;
    d.NPE = ((7 * H1 + 4 * d.HS + 255) / 256) * 256;
    d.PNQ = 0; d.PNK = H1; d.PNV = 2 * H1; d.PWQ = 3 * H1; d.PWK = 4 * H1; d.PWV = 4 * H1 + 256;
    d.NPO = ((4 * H1 + 512 + 255) / 256) * 256;
    d.ABW = 4 * d.HS; d.GR = S / 64; d.rope_perm = 0;
    return d;
}

struct Params {
    const float *x, *c, *ctx, *c_ctx, *ada_w, *ada_b, *norm_mix_g, *norm_ffn_g, *w_in_even, *gdn_conv_w, *gdn_a_log, *gdn_dt_bias, *gdn_norm_g,
                *lq1, *lk1, *lq2, *lk2, *subln_g, *w_in_odd, *na_rpb, *win_sink, *w_out, *ffn_wg, *ffn_wu, *ffn_wd, *final_g;
    float* out;
    unsigned* ctl;
    float* modv;
    act_t *wt_in, *wt_out, *wt_gu, *wt_dn;
    float* h;
    act_t* hb;
    act_t* u;
    act_t* proj;
    float* ab;
    act_t* y;
    act_t* hid;
    float *qkvact;
    float *gbuf, *betabuf;
    act_t *dq_b, *dk_b;
    act_t *dvT;
    act_t *nvT, *wvT;
    float *rope32, *rope64;
    act_t *wq_b, *wk_b;
    float *ogdn;
    float *odiff;
};

HD float silu_f(float x) { return x / (1.0f + expf(-x)); }
HD float sigmoid_f(float x) { return 1.0f / (1.0f + expf(-x)); }
HD float softplus_f(float x) { return x > 20.f ? x : log1pf(expf(x)); }
HD float lambda_init_of(int l) { return 0.8f - 0.6f * expf(-0.3f * (float)l); }

struct RowInfo { int lat, b, t, Tn, base; };
HD RowInfo row_info(const Dims& d, int row) {
    RowInfo r;
    if (row < d.ML) { r.lat = 1; r.b = row / d.S; r.t = row % d.S; r.Tn = d.S; r.base = r.b * d.S; }
    else { const int rr = row - d.ML; r.lat = 0; r.b = rr / d.CTX; r.t = rr % d.CTX; r.Tn = d.CTX; r.base = d.ML + r.b * d.CTX; }
    return r;
}

HD void st_mod(const Params& P, const Dims& d, int, long gid, long nth) {
    const long total = (long)d.DEPTH * (d.B + 1) * 6 * d.D;
    for (long i = gid; i < total; i += nth) {
        const int n = (int)(i % (6 * d.D)); const int b9 = (int)((i / (6 * d.D)) % (d.B + 1)); const int l = (int)(i / ((long)6 * d.D * (d.B + 1)));
        const float* cv = b9 < d.B ? P.c + (size_t)b9 * d.D : P.c_ctx;
        const float* w = P.ada_w + (size_t)l * d.D * 6 * d.D + n;
        float acc = 0.f;
        for (int k = 0; k < d.D; ++k) acc += silu_f(cv[k]) * w[(size_t)k * 6 * d.D];
        P.modv[i] = acc + P.ada_b[(size_t)l * 6 * d.D + n];
    }
}
HD void st_copy_h(const Params& P, const Dims& d, int, long gid, long nth) {
    const long nl = (long)d.ML * d.D, total = (long)d.M * d.D;
    for (long i = gid; i < total; i += nth) P.h[i] = i < nl ? P.x[i] : P.ctx[i - nl];
}
enum WKind { WK_IN_EVEN = 0, WK_IN_ODD = 1, WK_OUT = 2, WK_GATE = 3, WK_UP = 4, WK_DOWN = 5 };
HD int rope_il(int x, int n2) { return x < n2 ? 2 * x : 2 * (x - n2) + 1; }
HD int w_dstrow(const Dims& d, int kind, int j) {
    if (kind == WK_IN_EVEN) { const int H1 = d.HS * 128;
        if (j < 4 * H1) return j;
        if (j < 4 * H1 + 4 * d.HS) return d.PA + (j - 4 * H1);
        int o = j - 4 * H1 - 4 * d.HS;
        if (d.rope_perm && o < 2 * H1) o = (o & ~31) + rope_il(o & 31, 16);
        return d.PDQ + o; }
    if (kind == WK_IN_ODD) { const int H1 = d.HS * 128;
        if (d.rope_perm && j >= 3 * H1 && j < 4 * H1 + 256) return (j & ~63) + rope_il(j & 63, 32);
        return j; }
    if (kind == WK_GATE) return (j / 128) * 256 + (j % 128);
    if (kind == WK_UP) return (j / 128) * 256 + 128 + (j % 128);
    return j;
}
HD void w_src(const Params& P, const Dims& d, int kind, int layer, const float*& W, int& K, int& N, act_t*& dst) {
    const int i = layer / 2;
    switch (kind) {
        case WK_IN_EVEN: K = d.D; N = 7 * d.HS * 128 + 4 * d.HS; W = P.w_in_even + (size_t)i * K * N; dst = P.wt_in; break;
        case WK_IN_ODD:  K = d.D; N = 4 * d.HS * 128 + 512; W = P.w_in_odd + (size_t)i * K * N; dst = P.wt_in; break;
        case WK_OUT:     K = d.D; N = d.D; W = P.w_out + (size_t)layer * K * N; dst = P.wt_out; break;
        case WK_GATE:    K = d.D; N = d.FF; W = P.ffn_wg + (size_t)layer * K * N; dst = P.wt_gu; break;
        case WK_UP:      K = d.D; N = d.FF; W = P.ffn_wu + (size_t)layer * K * N; dst = P.wt_gu; break;
        default:         K = d.FF; N = d.D; W = P.ffn_wd + (size_t)layer * K * N; dst = P.wt_dn; break;
    }
}
HD void st_wconv(const Params& P, const Dims& d, int layer, int kind, long gid, long nth) {
    const float* W; int K, N; act_t* dst; w_src(P, d, kind, layer, W, K, N, dst);
    const long total = (long)K * N;
    for (long i = gid; i < total; i += nth) { const int k = (int)(i / N), j = (int)(i % N); stf(dst + (size_t)w_dstrow(d, kind, j) * K + k, W[i]); }
}
HD void st_wpad_even(const Params& P, const Dims& d, int, long gid, long nth) {
    const int r0 = d.PA + 4 * d.HS; const long total = (long)(d.NPE - r0) * d.D;
    for (long i = gid; i < total; i += nth) stf(P.wt_in + (size_t)r0 * d.D + i, 0.f);
}

HD void st_norm(const Params& P, const Dims& d, int layer, int which  , int nrows, long gid, long nth) {
    const float* g = (which ? P.norm_ffn_g : P.norm_mix_g) + (size_t)layer * d.D;
    for (long row = gid; row < nrows; row += nth) {
        const RowInfo ri = row_info(d, (int)row); const int b9 = ri.lat ? ri.b : d.B;
        const float* mv = P.modv + ((size_t)layer * (d.B + 1) + b9) * 6 * d.D;
        const float* shift = mv + (which ? 3 : 0) * d.D; const float* scale = mv + (which ? 4 : 1) * d.D;
        const float* hr = P.h + (size_t)row * d.D; float ss = 0.f;
        for (int k = 0; k < d.D; ++k) ss += hr[k] * hr[k];
        const float r = 1.0f / sqrtf(ss / (float)d.D + 1e-6f);
        for (int k = 0; k < d.D; ++k) stf(P.u + (size_t)row * d.D + k, hr[k] * r * g[k] * (1.0f + scale[k]) + shift[k]);
    }
}
HD void st_final_norm(const Params& P, const Dims& d, int, long gid, long nth) {
    for (long row = gid; row < d.ML; row += nth) {
        const float* hr = P.h + (size_t)row * d.D; float ss = 0.f;
        for (int k = 0; k < d.D; ++k) ss += hr[k] * hr[k];
        const float r = 1.0f / sqrtf(ss / (float)d.D + 1e-6f);
        for (int k = 0; k < d.D; ++k) P.out[(size_t)row * d.D + k] = hr[k] * r * P.final_g[k];
    }
}

HD void st_e_conv(const Params& P, const Dims& d, int layer, long gid, long nth) {
    const int C3 = 3 * d.HS * 128; const long total = (long)d.M * C3; const float* cw = P.gdn_conv_w + (size_t)(layer / 2) * 3 * C3;
    for (long i = gid; i < total; i += nth) {
        const int row = (int)(i / C3), ch = (int)(i % C3); const RowInfo ri = row_info(d, row);
        const act_t* p = P.proj + (size_t)row * d.NPE + ch;
        const float x0 = ldf(p), xm = ri.t > 0 ? ldf(p - d.NPE) : 0.f, xp = ri.t < ri.Tn - 1 ? ldf(p + d.NPE) : 0.f;
        P.qkvact[i] = silu_f(xm * cw[ch] + x0 * cw[C3 + ch] + xp * cw[2 * C3 + ch]);
    }
}
HD void st_e_l2(const Params& P, const Dims& d, int, long gid, long nth) {
    const int C3 = 3 * d.HS * 128; const long total = (long)d.M * 2 * d.HS;
    for (long i = gid; i < total; i += nth) {
        const int head = (int)(i % d.HS), which = (int)((i / d.HS) % 2), row = (int)(i / (2 * d.HS));
        float* p = P.qkvact + (size_t)row * C3 + which * d.HS * 128 + head * 128; float ss = 0.f;
        for (int e = 0; e < 128; ++e) ss += p[e] * p[e];
        const float r = 1.0f / sqrtf(ss + 1e-6f);
        for (int e = 0; e < 128; ++e) p[e] *= r;
    }
}
HD void st_e_gb(const Params& P, const Dims& d, int layer, long gid, long nth) {
    const long total = (long)d.M * 2 * d.HS; const int i2 = layer / 2;
    for (long i = gid; i < total; i += nth) {
        const int head = (int)(i % d.HS), dir = (int)((i / d.HS) % 2), row = (int)(i / (2 * d.HS));
        const float a = P.ab[(size_t)row * d.ABW + dir * d.HS + head], b = P.ab[(size_t)row * d.ABW + 2 * d.HS + dir * d.HS + head];
        const int pi = (i2 * 2 + dir) * d.HS + head;
        P.gbuf[i] = -expf(P.gdn_a_log[pi]) * softplus_f(a + P.gdn_dt_bias[pi]);
        P.betabuf[i] = sigmoid_f(b);
    }
}
HD float rope_inv(int i, int n) { return powf(10000.0f, -(float)(2 * i) / (float)n); }
HD void st_rope_tab(const Params& P, const Dims&, int, long gid, long nth) {
    for (long i = gid; i < 64 * 16 + 64 * 32; i += nth) {
        if (i < 64 * 16) { const int pos = (int)(i / 16), f = (int)(i % 16); const float ang = (float)pos * rope_inv(f, 32); P.rope32[2 * i] = cosf(ang); P.rope32[2 * i + 1] = sinf(ang); }
        else { const long k = i - 64 * 16; const int pos = (int)(k / 32), f = (int)(k % 32); const float ang = (float)pos * rope_inv(f, 64); P.rope64[2 * k] = cosf(ang); P.rope64[2 * k + 1] = sinf(ang); }
    }
}
HD void st_e_rope(const Params& P, const Dims& d, int, long gid, long nth) {
    const long total = (long)d.M * 2 * d.HS * 2 * 2 * 16;
    for (long idx = gid; idx < total; idx += nth) {
        long r = idx; const int i = (int)(r % 16); r /= 16; const int half = (int)(r % 2); r /= 2; const int comp = (int)(r % 2); r /= 2;
        const int head = (int)(r % d.HS); r /= d.HS; const int qk = (int)(r % 2); r /= 2; const int row = (int)r;
        const RowInfo ri = row_info(d, row);
        const int off = head * 128 + comp * 64 + half * 32;
        const act_t* src = P.proj + (size_t)row * d.NPE + (qk ? d.PDK : d.PDQ) + off;
        act_t* dst = (qk ? P.dk_b : P.dq_b) + (size_t)row * d.HS * 128 + off;
        const float x1 = ldf(src + i), x2 = ldf(src + 16 + i);
        if (ri.lat) { const int pos = half == 0 ? ri.t / 64 : ri.t % 64; const float cs = P.rope32[(pos * 16 + i) * 2], sn = P.rope32[(pos * 16 + i) * 2 + 1];
            stf(dst + i, x1 * cs - x2 * sn); stf(dst + 16 + i, x2 * cs + x1 * sn); }
        else { stf(dst + i, x1); stf(dst + 16 + i, x2); }
    }
}
HD void st_vT(const Params& P, const Dims& d, act_t* vT, int np, int col0, int nh, long gid, long nth) {
    const int KT = d.S + d.CTX; const long total = (long)d.B * nh * 128 * KT;
    for (long idx = gid; idx < total; idx += nth) {
        const int key = (int)(idx % KT); long r = idx / KT; const int e = (int)(r % 128); r /= 128; const int head = (int)(r % nh); const int b = (int)(r / nh);
        const int row = key < d.S ? b * d.S + key : d.ML + b * d.CTX + (key - d.S);
        vT[idx] = P.proj[(size_t)row * np + col0 + head * 128 + e];
    }
}
template <class PF> HD void st_e_gdn(const Params& P, const Dims& d, int, long gid, long nth, PF priv, int ps) {
    const int C3 = 3 * d.HS * 128; const long total = (long)d.B * 2 * d.HS * 128; const float scale = 0.08838834764831845f;
    for (long idx = gid; idx < total; idx += nth) {
        const int e = (int)(idx % 128), head = (int)((idx / 128) % d.HS), dir = (int)((idx / (128 * d.HS)) % 2), b = (int)(idx / (128 * d.HS * 2));
        for (int j = 0; j < 128; ++j) priv[j * ps] = 0.f;
        for (int ph = 0; ph < 2; ++ph) {
            const int Tn = ph == 0 ? d.CTX : d.S, base = ph == 0 ? d.ML + b * d.CTX : b * d.S;
            for (int step = 0; step < Tn; ++step) {
                const int row = base + (dir == 0 ? step : Tn - 1 - step);
                const float* q = P.qkvact + (size_t)row * C3 + head * 128; const float* k = q + d.HS * 128; const float ve = q[2 * d.HS * 128 + e];
                const float g = P.gbuf[((size_t)row * 2 + dir) * d.HS + head], beta = P.betabuf[((size_t)row * 2 + dir) * d.HS + head];
                const float dec = expf(g); float kv = 0.f;
#pragma unroll 8
                for (int j = 0; j < 128; ++j) { const float sj = priv[j * ps] * dec; priv[j * ps] = sj; kv += k[j] * sj; }
                const float vn = beta * (ve - kv); float o = 0.f;
#pragma unroll 8
                for (int j = 0; j < 128; ++j) { const float sj = priv[j * ps] + k[j] * vn; priv[j * ps] = sj; o += q[j] * sj; }
                P.ogdn[(((size_t)dir * d.M + row) * d.HS + head) * 128 + e] = o * scale;
            }
        }
    }
}
struct MS { float m, l; };
HD void ms_init(MS& a) { a.m = -INFINITY; a.l = 0.f; }
HD void ms_add(MS& a, float s) { const float mn = fmaxf(a.m, s); a.l = a.l * expf(a.m - mn) + expf(s - mn); a.m = mn; }
HD float diff_lambda(const Params& P, int layer) {
    const int i2 = layer / 2; float s1 = 0.f, s2 = 0.f;
    for (int j = 0; j < 64; ++j) { s1 += P.lq1[i2 * 64 + j] * P.lk1[i2 * 64 + j]; s2 += P.lq2[i2 * 64 + j] * P.lk2[i2 * 64 + j]; }
    return expf(s1) - expf(s2) + lambda_init_of(layer);
}
HD void st_e_diff(const Params& P, const Dims& d, int layer, int nrows, long gid, long nth) {
    const long total = (long)nrows * d.HS * 4; const int H1 = d.HS * 128;
    for (long idx = gid; idx < total; idx += nth) {
        const int row = (int)(idx % nrows); const int r2 = (int)(idx / nrows); const int eh = r2 % 2, c = (r2 / 2) % 2, head = r2 / 4;
        const RowInfo ri = row_info(d, row);
        float acc[64];
        const act_t* qp = P.dq_b + (size_t)row * H1 + head * 128 + c * 64;
#pragma unroll
        for (int j = 0; j < 64; ++j) acc[j] = 0.f;
        const int KT = d.S + d.CTX;
        MS a; ms_init(a);
        const int nseg = ri.lat ? 2 : 1;
        for (int pass = 0; pass < 2; ++pass)
            for (int seg = 0; seg < nseg; ++seg) {
                const int kb = (ri.lat && seg == 0) ? ri.b * d.S : d.ML + ri.b * d.CTX, kn = (ri.lat && seg == 0) ? d.S : d.CTX;
                for (int j = 0; j < kn; ++j) {
                    const act_t* kp = P.dk_b + (size_t)(kb + j) * H1 + head * 128 + c * 64; float t = 0.f;
#pragma unroll 8
                    for (int e = 0; e < 64; ++e) t += ldf(qp + e) * ldf(kp + e);
                    t *= 0.125f;
                    if (pass == 0) ms_add(a, t);
                    else { const float p = expf(t - a.m) / a.l;
                        const int key = (ri.lat && seg == 0) ? j : d.S + j;
                        const act_t* vp = P.dvT + ((size_t)(ri.b * d.HS + head) * 128 + eh * 64) * KT + key;
#pragma unroll
                        for (int e = 0; e < 64; ++e) acc[e] += p * ldf(vp + (size_t)e * KT); }
                }
            }
        float* op = P.odiff + ((size_t)c * d.M + row) * H1 + head * 128 + eh * 64;
#pragma unroll
        for (int e = 0; e < 64; ++e) op[e] = acc[e];
    }
}
HD void st_e_merge(const Params& P, const Dims& d, int layer, int nrows, long gid, long nth) {
    const int i2 = layer / 2, H1 = d.HS * 128; const long total = (long)nrows * 2 * d.HS; const float li = lambda_init_of(layer); const float lam = diff_lambda(P, layer);
    for (long idx = gid; idx < total; idx += nth) {
        const int hs = (int)(idx % (2 * d.HS)), row = (int)(idx / (2 * d.HS));
        if (hs < d.HS) {
            const float* o0 = P.ogdn + ((size_t)row * d.HS + hs) * 128; const float* o1 = o0 + (size_t)d.M * H1; float ss = 0.f;
            for (int e = 0; e < 128; ++e) { const float o = o0[e] + o1[e]; ss += o * o; }
            const float r = 1.0f / sqrtf(ss / 128.f + 1e-6f);
            for (int e = 0; e < 128; ++e) { const float z = ldf(P.proj + (size_t)row * d.NPE + d.PZ + hs * 128 + e);
                stf(P.y + (size_t)row * d.D + hs * 128 + e, (o0[e] + o1[e]) * r * P.gdn_norm_g[i2 * 128 + e] * silu_f(z)); }
        } else {
            const int hh = hs - d.HS; const float* o0 = P.odiff + (size_t)row * H1 + hh * 128; const float* o1 = o0 + (size_t)d.M * H1; float ss = 0.f;
            for (int e = 0; e < 128; ++e) { const float o = o0[e] - lam * o1[e]; ss += o * o; }
            const float r = 1.0f / sqrtf(ss / 128.f + 1e-6f);
            for (int e = 0; e < 128; ++e) stf(P.y + (size_t)row * d.D + H1 + hh * 128 + e, (o0[e] - lam * o1[e]) * r * P.subln_g[i2 * 128 + e] * (1.0f - li));
        }
    }
}

HD void st_o_rope(const Params& P, const Dims& d, int, long gid, long nth) {
    const int NS = d.HS + 2; const long total = (long)d.M * NS * 2 * 32;
    for (long idx = gid; idx < total; idx += nth) {
        long r = idx; const int i = (int)(r % 32); r /= 32; const int half = (int)(r % 2); r /= 2; const int slot = (int)(r % NS); r /= NS; const int row = (int)r;
        const RowInfo ri = row_info(d, row);
        const act_t* src = P.proj + (size_t)row * d.NPO + (slot < d.HS ? d.PWQ + slot * 128 : d.PWK + (slot - d.HS) * 128) + half * 64;
        act_t* dst = (slot < d.HS ? P.wq_b + ((size_t)row * d.HS + slot) * 128 : P.wk_b + ((size_t)row * 2 + (slot - d.HS)) * 128) + half * 64;
        const float x1 = ldf(src + i), x2 = ldf(src + 32 + i);
        if (ri.lat) { const int pos = half == 0 ? ri.t / 64 : ri.t % 64; const float cs = P.rope64[(pos * 32 + i) * 2], sn = P.rope64[(pos * 32 + i) * 2 + 1];
            stf(dst + i, x1 * cs - x2 * sn); stf(dst + 32 + i, x2 * cs + x1 * sn); }
        else { stf(dst + i, x1); stf(dst + 32 + i, x2); }
    }
}
HD int clampi(int v, int lo, int hi) { return v < lo ? lo : (v > hi ? hi : v); }
HD void st_o_na(const Params& P, const Dims& d, int layer, int nrows, long gid, long nth) {
    const int i2 = layer / 2; const long total = (long)nrows * d.HS * 4; const float scale = 0.08838834764831845f;
    for (long idx = gid; idx < total; idx += nth) {
        const int row = (int)(idx % nrows); const int r2 = (int)(idx / nrows); const int eq = r2 % 4, head = r2 / 4;
        const RowInfo ri = row_info(d, row);
        float acc[32];
        const act_t* qp = P.proj + (size_t)row * d.NPO + d.PNQ + head * 128;
#pragma unroll
        for (int j = 0; j < 32; ++j) acc[j] = 0.f;
        const int r = ri.t / 64, c = ri.t % 64;
        const int kr = d.GR < 8 ? d.GR : 8;
        const int r0 = clampi(r - kr / 2, 0, d.GR - kr), c0 = clampi(c - 8, 0, 64 - 16);
        const float* rpb = P.na_rpb + ((size_t)i2 * d.HS + head) * 15 * 31;
        const int nloc = ri.lat ? kr * 16 : 0;
        MS a; ms_init(a);
        for (int pass = 0; pass < 2; ++pass)
            for (int j = 0; j < nloc + d.CTX; ++j) {
                int krow; float bias = 0.f;
                if (j < nloc) { const int rr = r0 + j / 16, cc = c0 + j % 16; krow = ri.b * d.S + rr * 64 + cc; bias = rpb[(rr - r + 7) * 31 + (cc - c + 15)]; }
                else krow = d.ML + ri.b * d.CTX + (j - nloc);
                const act_t* kp = P.proj + (size_t)krow * d.NPO + d.PNK + head * 128; float t = 0.f;
#pragma unroll 8
                for (int e = 0; e < 128; ++e) t += ldf(qp + e) * ldf(kp + e);
                t = t * scale + bias;
                if (pass == 0) ms_add(a, t);
                else { const float p = expf(t - a.m) / a.l; const int KT = d.S + d.CTX; const int key = krow < d.ML ? krow - ri.b * d.S : d.S + (krow - d.ML - ri.b * d.CTX);
                    const act_t* vp = P.nvT + ((size_t)(ri.b * d.HS + head) * 128 + eq * 32) * KT + key;
#pragma unroll
                    for (int e = 0; e < 32; ++e) acc[e] += p * ldf(vp + (size_t)e * KT); }
            }
        act_t* op = P.y + (size_t)row * d.D + head * 128 + eq * 32;
#pragma unroll
        for (int e = 0; e < 32; ++e) stf(op + e, acc[e]);
    }
}
HD void st_o_win(const Params& P, const Dims& d, int layer, int nrows, long gid, long nth) {
    const int i2 = layer / 2; const long total = (long)nrows * d.HS * 4; const float scale = 0.08838834764831845f; const int grp = d.HS / 2;
    for (long idx = gid; idx < total; idx += nth) {
        const int row = (int)(idx % nrows); const int r2 = (int)(idx / nrows); const int eq = r2 % 4, head = r2 / 4;
        const RowInfo ri = row_info(d, row); const int kvh = head / grp;
        float acc[32];
        const act_t* qp = P.wq_b + ((size_t)row * d.HS + head) * 128;
#pragma unroll
        for (int j = 0; j < 32; ++j) acc[j] = 0.f;
        const int lo = ri.lat ? (ri.t - 128 < 0 ? 0 : ri.t - 128) : 0, hi = ri.lat ? (ri.t + 128 > d.S - 1 ? d.S - 1 : ri.t + 128) : -1;
        const int nloc = hi - lo + 1;
        const float sink = P.win_sink[i2 * d.HS + head];
        MS a; ms_init(a);
        for (int pass = 0; pass < 2; ++pass) {
            for (int j = 0; j < nloc + d.CTX; ++j) {
                const int krow = j < nloc ? ri.b * d.S + lo + j : d.ML + ri.b * d.CTX + (j - nloc);
                const act_t* kp = P.wk_b + ((size_t)krow * 2 + kvh) * 128; float t = 0.f;
#pragma unroll 8
                for (int e = 0; e < 128; ++e) t += ldf(qp + e) * ldf(kp + e);
                t *= scale;
                if (pass == 0) ms_add(a, t);
                else { const float p = expf(t - a.m) / a.l; const int KT = d.S + d.CTX; const int key = krow < d.ML ? krow - ri.b * d.S : d.S + (krow - d.ML - ri.b * d.CTX);
                    const act_t* vp = P.wvT + ((size_t)(ri.b * 2 + kvh) * 128 + eq * 32) * KT + key;
#pragma unroll
                    for (int e = 0; e < 32; ++e) acc[e] += p * ldf(vp + (size_t)e * KT); }
            }
            if (pass == 0) ms_add(a, sink);
        }
        act_t* op = P.y + (size_t)row * d.D + d.HS * 128 + head * 128 + eq * 32;
#pragma unroll
        for (int e = 0; e < 32; ++e) stf(op + e, acc[e]);
    }
}

HD const float* gate_vec(const Params& P, const Dims& d, int layer, int row, int chunk) {
    const RowInfo ri = row_info(d, row); const int b9 = ri.lat ? ri.b : d.B;
    return P.modv + ((size_t)layer * (d.B + 1) + b9) * 6 * d.D + (size_t)chunk * d.D;
}
#ifndef HOST_TEST
namespace pg8 {
#define PG8_LAS __attribute__((address_space(3)))
typedef unsigned short bf16_t;
typedef short bf16x8 __attribute__((ext_vector_type(8)));
typedef float f32x4 __attribute__((ext_vector_type(4)));
typedef unsigned u32x4 __attribute__((ext_vector_type(4)));
typedef unsigned u32x2 __attribute__((ext_vector_type(2)));
constexpr int BM = 256, BK = 64, HALF = 128, HTB = HALF * BK * 2  , STAGE_BYTES = 8 * HTB, NXCD = 8, WGM = 8;

__host__ __device__ __forceinline__ int lds_byte(int r, int c) { const int st = (r >> 4) * 2 + (c >> 5), rr = r & 15, cc = c & 31, ob = rr * 64 + cc * 2; return st * 1024 + (ob ^ (((ob >> 9) & 1) << 5)); }
__host__ __device__ __forceinline__ void stage_rc(int b, int& R, int& C) { const int st = b / 1024, sb = b % 1024, swz = sb ^ (((sb >> 9) & 1) << 5); R = (st >> 1) * 16 + swz / 64; C = (st & 1) * 32 + (swz % 64) / 2; }
__host__ __device__ __forceinline__ int perm32(int rho) { const int n = rho >> 4, i = rho & 15; return 8 * (i >> 2) + 4 * n + (i & 3); }

struct Unit { int pm, pn, kofs, nt, part; };
struct Gemm { const bf16_t* A; const bf16_t* Bt; int M, N, K; };

struct StaticOrder {
    int nM, nN, nwg, G, c, ntK;
    __host__ __device__ void init(int M, int N, int G_, int c_, int K = 0) { nM = M / BM; nN = N / BM; nwg = nM * nN; G = G_; c = c_; ntK = K / BK; }
    __host__ __device__ bool next(int i, Unit& u) const {
        const long L = (long)i * G + c; if (L >= nwg) return false;
        int wgid = (int)L; { const int q = nwg / NXCD, r = nwg % NXCD, xcd = wgid % NXCD, off = wgid / NXCD; wgid = (xcd < r ? xcd * (q + 1) : r * (q + 1) + (xcd - r) * q) + off; }
        const int nig = WGM * nN, gid = wgid / nig, fm = gid * WGM, gsz = (nM - fm) < WGM ? (nM - fm) : WGM;
        u.pm = fm + ((wgid % nig) % gsz); u.pn = (wgid % nig) / gsz; u.kofs = 0; u.nt = ntK; u.part = -1; return true;
    }
    __device__ __forceinline__ void a_ready(const Unit&) const {}
    __device__ __forceinline__ void done(const Unit&) const {}
};
struct SplitOrder {
    StaticOrder lat; int nlatu, nsplit, nN, pm0, ntq, kq_bytes;
    __host__ __device__ void init(int Mlat, int Mall, int N, int G_, int c_, int K, int parts) { lat.init(Mlat, N, G_, c_, K); nlatu = lat.nwg; nN = N / BM; pm0 = Mlat / BM;
        nsplit = ((Mall - Mlat) / BM) * nN * parts; ntq = K / BK / parts; kq_bytes = (K / parts) * 2; parts_ = parts; }
    int parts_;
    __host__ __device__ bool next(int i, Unit& u) const {
        const long L = (long)i * lat.G + lat.c;
        if (L < nlatu) return lat.next(i, u);
        const int e = (int)(L - nlatu); if (e >= nsplit) return false;
        const int tile = e / parts_, part = e % parts_, nrt = nsplit / parts_ / nN;
        u.pm = pm0 + tile % nrt; u.pn = tile / nrt; u.kofs = part * kq_bytes; u.nt = ntq; u.part = part; return true;
    }
    __device__ __forceinline__ void a_ready(const Unit&) const {}
    __device__ __forceinline__ void done(const Unit&) const {}
};
__device__ __forceinline__ unsigned cvt_pk_bf16(float lo, float hi) { unsigned r; asm volatile("v_cvt_pk_bf16_f32 %0, %1, %2" : "=v"(r) : "v"(lo), "v"(hi)); return r; }
struct EpiProj {
    static constexpr bool PERM = true, AFTER_DRAIN = false;
    bf16_t* O; int ldc; float* ab; int abw; int ab_tile;
    int rope_lo, rope_hi, rope_n2;
    const float* rope_tab;
    __device__ __forceinline__ void operator()(const f32x4 (&acc)[2][2][4][2], const Unit& u, int wr, int wc, int fr, int fq) const {
        const int row0 = u.pm * BM + wr * 64 + fr;
        if (u.pn == ab_tile) {
            if (wc == 0) {
#pragma unroll
                for (int ai = 0; ai < 2; ++ai)
#pragma unroll
                    for (int m = 0; m < 4; ++m) { float* p = ab + (size_t)(row0 + ai * HALF + m * 16) * abw + 8 * fq;
                        *(f32x4*)p = acc[ai][0][m][0]; *(f32x4*)(p + 4) = acc[ai][0][m][1]; }
            }
            return;
        }
        const int col0 = u.pn * BM + wc * 32 + 8 * fq;
        const bool rope = u.pn >= rope_lo && u.pn < rope_hi && u.pm < 64;
        const int axis = rope_n2 == 16 ? (wc & 1) : ((wc >> 1) & 1), j0 = rope_n2 == 16 ? 4 * fq : 16 * (wc & 1) + 4 * fq;
#pragma unroll
        for (int ai = 0; ai < 2; ++ai)
#pragma unroll
            for (int m = 0; m < 4; ++m) { const int row = row0 + ai * HALF + m * 16; bf16_t* rowp = O + (size_t)row * ldc + col0;
                f32x4 cs0 = {1.f, 0.f, 1.f, 0.f}, cs1 = cs0;
                if (rope) { const int t = row & 2047, pos = axis ? (t & 63) : (t >> 6); const float* tp = rope_tab + ((size_t)pos * rope_n2 + j0) * 2; cs0 = *(const f32x4*)tp; cs1 = *(const f32x4*)(tp + 4); }
#pragma unroll
                for (int bj = 0; bj < 2; ++bj) { f32x4 v0 = acc[ai][bj][m][0], v1 = acc[ai][bj][m][1];
                    if (rope) { v0 = (f32x4){v0[0] * cs0[0] - v0[1] * cs0[1], v0[1] * cs0[0] + v0[0] * cs0[1], v0[2] * cs0[2] - v0[3] * cs0[3], v0[3] * cs0[2] + v0[2] * cs0[3]};
                                v1 = (f32x4){v1[0] * cs1[0] - v1[1] * cs1[1], v1[1] * cs1[0] + v1[0] * cs1[1], v1[2] * cs1[2] - v1[3] * cs1[3], v1[3] * cs1[2] + v1[2] * cs1[3]}; }
                    u32x4 w; w.x = cvt_pk_bf16(v0[0], v0[1]); w.y = cvt_pk_bf16(v0[2], v0[3]); w.z = cvt_pk_bf16(v1[0], v1[1]); w.w = cvt_pk_bf16(v1[2], v1[3]);
                    *(u32x4*)(rowp + bj * HALF) = w; } }
    }
};
template <bool IN32> struct EpiResidT {
    static constexpr bool PERM = false, AFTER_DRAIN = false;
    bf16_t* H; const float* Hin32; int ldc; const float* gate0; int S, ML, B, D6;
    float* part;
    __device__ __forceinline__ void operator()(const f32x4 (&acc)[2][2][4][2], const Unit& u, int wr, int wc, int fr, int fq) const {
        const int r0t = u.pm * BM; const int b9 = r0t < ML ? r0t / S : B;
        const float* gate = gate0 + (size_t)b9 * D6;
        const int row0 = r0t + wr * 64 + fr, col0 = u.pn * BM + wc * 32 + 4 * fq;
        f32x4 gv[2][2];
#pragma unroll
        for (int bj = 0; bj < 2; ++bj)
#pragma unroll
            for (int n = 0; n < 2; ++n) gv[bj][n] = *(const f32x4*)(gate + col0 + bj * HALF + n * 16);
        if (u.part >= 0) {
            bf16_t* pb = (bf16_t*)part + ((size_t)u.part * (B * 256) + (row0 - ML)) * ldc + col0;
#pragma unroll
            for (int ai = 0; ai < 2; ++ai)
#pragma unroll
                for (int m = 0; m < 4; ++m) { bf16_t* rowp = pb + (size_t)(ai * HALF + m * 16) * ldc;
#pragma unroll
                    for (int bj = 0; bj < 2; ++bj)
#pragma unroll
                        for (int n = 0; n < 2; ++n) { const f32x4 t = gv[bj][n] * acc[ai][bj][m][n]; *(u32x2*)(rowp + bj * HALF + n * 16) = (u32x2){cvt_pk_bf16(t[0], t[1]), cvt_pk_bf16(t[2], t[3])}; } }
            return;
        }
#pragma unroll
        for (int ai = 0; ai < 2; ++ai)
#pragma unroll
            for (int m = 0; m < 4; ++m) { const size_t ro = (size_t)(row0 + ai * HALF + m * 16) * ldc + col0;
#pragma unroll
                for (int bj = 0; bj < 2; ++bj)
#pragma unroll
                    for (int n = 0; n < 2; ++n) { const int co = bj * HALF + n * 16; f32x4 hin;
                        if constexpr (IN32) hin = *(const f32x4*)(Hin32 + ro + co);
                        else { const u32x2 w = *(const u32x2*)(H + ro + co);
                            hin = (f32x4){__builtin_bit_cast(float, w.x << 16), __builtin_bit_cast(float, w.x & 0xffff0000u), __builtin_bit_cast(float, w.y << 16), __builtin_bit_cast(float, w.y & 0xffff0000u)}; }
                        const f32x4 t = hin + gv[bj][n] * acc[ai][bj][m][n];
                        *(u32x2*)(H + ro + co) = (u32x2){cvt_pk_bf16(t[0], t[1]), cvt_pk_bf16(t[2], t[3])}; } }
    }
};
struct EpiSwiGLU {
    static constexpr bool PERM = true, AFTER_DRAIN = false;
    bf16_t* O; int ldc; int mode;
    __device__ __forceinline__ void operator()(const f32x4 (&acc)[2][2][4][2], const Unit& u, int wr, int wc, int fr, int fq) const {
        if (mode == 2) {
            f32x4 s = acc[0][0][0][0];
#pragma unroll
            for (int ai = 0; ai < 2; ++ai)
#pragma unroll
                for (int bj = 0; bj < 2; ++bj)
#pragma unroll
                    for (int m = 0; m < 4; ++m)
#pragma unroll
                        for (int n = 0; n < 2; ++n) s = s + acc[ai][bj][m][n];
            if (s[0] + s[1] + s[2] + s[3] == 1.2345e33f) O[0] = 1;
            return; }
        const int row0 = u.pm * BM + wr * 64 + fr, col0 = u.pn * HALF + wc * 32 + 8 * fq;
#pragma unroll
        for (int ai = 0; ai < 2; ++ai)
#pragma unroll
            for (int m = 0; m < 4; ++m) { float o[8];
#pragma unroll
                for (int n = 0; n < 2; ++n)
#pragma unroll
                    for (int j = 0; j < 4; ++j) { const float g = acc[ai][0][m][n][j], up = acc[ai][1][m][n][j]; o[n * 4 + j] = g * __builtin_amdgcn_rcpf(1.0f + __expf(-g)) * up; }
                u32x4 w; w.x = cvt_pk_bf16(o[0], o[1]); w.y = cvt_pk_bf16(o[2], o[3]); w.z = cvt_pk_bf16(o[4], o[5]); w.w = cvt_pk_bf16(o[6], o[7]);
                if (mode == 0 || w.x == 0x12345678u) *(u32x4*)(O + (size_t)(row0 + ai * HALF + m * 16) * ldc + col0) = w; }
    }
};
template <class Epi, class Sched, bool ALIGN_EPI = false, bool SP2 = false>
__device__ __forceinline__ void gemm_phase(PG8_LAS unsigned char* lds, const Gemm g, const Sched& S, const Epi& E) {
    int tid = threadIdx.x; asm volatile("" : "+v"(tid)); const int wid = __builtin_amdgcn_readfirstlane(tid >> 6), lane = tid & 63, wr = wid >> 2, wc = wid & 3, fr = lane & 15, fq = lane >> 4;
    const int K = g.K;
    unsigned voffA[2], voffB[2];
#pragma unroll
    for (int i = 0; i < 2; ++i) { int R, C; stage_rc(tid * 16 + i * 8192, R, C); const int Rb = Epi::PERM ? ((R & ~31) + perm32(R & 31)) : R;
        voffA[i] = (unsigned)(R * K + C) * 2u; voffB[i] = (unsigned)(Rb * K + C) * 2u; }
    const size_t kstep = (size_t)(BK * 2);
    const size_t hstep = (size_t)HALF * K * 2;
    const size_t tstep = 2 * hstep;
    const unsigned ldsw = (unsigned)wid * 1024u;
    const int aoff = lds_byte(wr * 64 + fr, fq * 8), boff = lds_byte(wc * 32 + fr, fq * 8);
#define PG8_SA(b, h) (((b) * 2 + (h)) * HTB)
#define PG8_SB(b, h) ((4 + (b) * 2 + (h)) * HTB)
#define PG8_STAGE(bufoff, gbase, voff) do { _Pragma("unroll") for (int _i = 0; _i < 2; ++_i) \
        __builtin_amdgcn_global_load_lds((const unsigned*)((const char*)(gbase) + (voff)[_i]), (PG8_LAS unsigned*)(lds + (bufoff) + ldsw + _i * 8192), 16, 0, 0); } while (0)
#define PG8_LDA(dst, b, h) do { _Pragma("unroll") for (int m = 0; m < 4; ++m) _Pragma("unroll") for (int k = 0; k < 2; ++k) dst[m][k] = *(const PG8_LAS bf16x8*)(lds + PG8_SA(b, h) + aoff + m * 2048 + k * 1024); } while (0)
#define PG8_LDB(dst, b, h) do { _Pragma("unroll") for (int n = 0; n < 2; ++n) _Pragma("unroll") for (int k = 0; k < 2; ++k) dst[n][k] = *(const PG8_LAS bf16x8*)(lds + PG8_SB(b, h) + boff + n * 2048 + k * 1024); } while (0)
#define PG8_MMA(ai, bj, At, Bt) do { __builtin_amdgcn_s_setprio(1); _Pragma("unroll") for (int m = 0; m < 4; ++m) _Pragma("unroll") for (int n = 0; n < 2; ++n) _Pragma("unroll") for (int k = 0; k < 2; ++k) \
        acc[ai][bj][m][n] = __builtin_amdgcn_mfma_f32_16x16x32_bf16(Bt[n][k], At[m][k], acc[ai][bj][m][n], 0, 0, 0); __builtin_amdgcn_s_setprio(0); } while (0)
#define PG8_WAIT_V(n) asm volatile("s_waitcnt vmcnt(" #n ")" ::: "memory")
#define PG8_WAIT_L(n) asm volatile("s_waitcnt lgkmcnt(" #n ")" ::: "memory")
#define PG8_BAR __builtin_amdgcn_s_barrier()
#define PG8_SCHED __builtin_amdgcn_sched_barrier(0)
    Unit cur, nxt; int ui = 0;
    if (!S.next(0, cur)) return;
    f32x4 acc[2][2][4][2];
#pragma unroll
    for (int a = 0; a < 2; ++a)
#pragma unroll
        for (int b = 0; b < 2; ++b)
#pragma unroll
            for (int m = 0; m < 4; ++m)
#pragma unroll
                for (int n = 0; n < 2; ++n) acc[a][b][m][n] = (f32x4){0.f, 0.f, 0.f, 0.f};
    bf16x8 At[4][2], B0[2][2], B1[2][2];
    const char* cA = (const char*)g.A + (size_t)cur.pm * tstep + cur.kofs; const char* cB = (const char*)g.Bt + (size_t)cur.pn * tstep + cur.kofs; int nt = cur.nt;
    S.a_ready(cur);
    if constexpr (SP2) {
        PG8_STAGE(PG8_SB(0, 0), cB, voffB); PG8_STAGE(PG8_SB(0, 1), cB + hstep, voffB); PG8_STAGE(PG8_SA(0, 0), cA, voffA); PG8_STAGE(PG8_SA(0, 1), cA + hstep, voffA);
        if (wr == 1) PG8_BAR;
        PG8_WAIT_V(2); PG8_BAR;
        PG8_STAGE(PG8_SB(1, 0), cB + kstep, voffB); PG8_STAGE(PG8_SA(1, 0), cA + kstep, voffA); PG8_STAGE(PG8_SB(1, 1), cB + hstep + kstep, voffB);
        PG8_WAIT_V(6); PG8_BAR;
    } else {
        PG8_STAGE(PG8_SB(0, 0), cB, voffB); PG8_STAGE(PG8_SA(0, 0), cA, voffA); PG8_STAGE(PG8_SB(0, 1), cB + hstep, voffB); PG8_STAGE(PG8_SA(0, 1), cA + hstep, voffA);
        if (wr == 1) PG8_BAR;
        PG8_WAIT_V(4); PG8_BAR;
        PG8_STAGE(PG8_SB(1, 0), cB + kstep, voffB); PG8_STAGE(PG8_SA(1, 0), cA + kstep, voffA); PG8_STAGE(PG8_SB(1, 1), cB + hstep + kstep, voffB);
        PG8_WAIT_V(6); PG8_BAR;
    }
    for (;;) {
        const bool has_next = S.next(ui + 1, nxt);
        const char* nA = has_next ? (const char*)g.A + (size_t)nxt.pm * tstep + nxt.kofs : cA; const char* nB = has_next ? (const char*)g.Bt + (size_t)nxt.pn * tstep + nxt.kofs : cB;
        for (int t = 0; t < nt; t += 2) {
            const bool last = (t == nt - 2);
            const char* a1 = cA + (size_t)(t + 1) * kstep;
            const char* a2 = last ? nA : cA + (size_t)(t + 2) * kstep; const char* b2 = last ? nB : cB + (size_t)(t + 2) * kstep;
            const char* a3 = a2 + kstep; const char* b3 = b2 + kstep;
            if (last && has_next) S.a_ready(nxt);
            if constexpr (SP2) {
            PG8_LDB(B0, 0, 0); PG8_LDB(B1, 0, 1); PG8_SCHED; PG8_LDA(At, 0, 0); PG8_STAGE(PG8_SA(1, 1), a1 + hstep, voffA);
            PG8_WAIT_V(8); PG8_WAIT_L(0); PG8_BAR; PG8_MMA(0, 0, At, B0); PG8_MMA(0, 1, At, B1); PG8_BAR; PG8_SCHED;
            PG8_LDA(At, 0, 1); PG8_STAGE(PG8_SB(0, 0), b2, voffB); PG8_STAGE(PG8_SB(0, 1), b2 + hstep, voffB); PG8_STAGE(PG8_SA(0, 0), a2, voffA);
            PG8_WAIT_V(8); PG8_WAIT_L(0); PG8_BAR; PG8_MMA(1, 0, At, B0); PG8_MMA(1, 1, At, B1); PG8_BAR; PG8_SCHED;
            PG8_LDB(B0, 1, 0); PG8_LDB(B1, 1, 1); PG8_SCHED; PG8_LDA(At, 1, 0); PG8_STAGE(PG8_SA(0, 1), a2 + hstep, voffA);
            PG8_WAIT_V(8); PG8_WAIT_L(0); PG8_BAR; PG8_MMA(0, 0, At, B0); PG8_MMA(0, 1, At, B1); PG8_BAR; PG8_SCHED;
            PG8_LDA(At, 1, 1); PG8_STAGE(PG8_SB(1, 0), b3, voffB); PG8_STAGE(PG8_SB(1, 1), b3 + hstep, voffB); PG8_STAGE(PG8_SA(1, 0), a3, voffA);
            PG8_WAIT_V(8); PG8_WAIT_L(0); PG8_BAR; PG8_MMA(1, 0, At, B0); PG8_MMA(1, 1, At, B1); PG8_BAR; PG8_SCHED;
            } else {
            PG8_LDB(B0, 0, 0); PG8_SCHED; PG8_LDA(At, 0, 0); PG8_STAGE(PG8_SA(1, 1), a1 + hstep, voffA);
            PG8_WAIT_L(8); PG8_BAR; PG8_WAIT_L(0); PG8_MMA(0, 0, At, B0); PG8_BAR; PG8_SCHED;
            PG8_LDB(B1, 0, 1); PG8_STAGE(PG8_SB(0, 0), b2, voffB);
            PG8_BAR; PG8_WAIT_L(0); PG8_MMA(0, 1, At, B1); PG8_BAR;
            PG8_LDA(At, 0, 1); PG8_STAGE(PG8_SA(0, 0), a2, voffA);
            PG8_BAR; PG8_WAIT_L(0); PG8_MMA(1, 0, At, B0); PG8_BAR; PG8_SCHED;
            PG8_STAGE(PG8_SB(0, 1), b2 + hstep, voffB);
            PG8_WAIT_V(6); PG8_BAR; PG8_MMA(1, 1, At, B1); PG8_BAR;
            PG8_LDB(B0, 1, 0); PG8_SCHED; PG8_LDA(At, 1, 0); PG8_STAGE(PG8_SA(0, 1), a2 + hstep, voffA);
            PG8_WAIT_L(8); PG8_BAR; PG8_WAIT_L(0); PG8_MMA(0, 0, At, B0); PG8_BAR; PG8_SCHED;
            PG8_LDB(B1, 1, 1); PG8_STAGE(PG8_SB(1, 0), b3, voffB);
            PG8_BAR; PG8_WAIT_L(0); PG8_MMA(0, 1, At, B1); PG8_BAR;
            PG8_LDA(At, 1, 1); PG8_STAGE(PG8_SA(1, 0), a3, voffA);
            PG8_BAR; PG8_WAIT_L(0); PG8_MMA(1, 0, At, B0); PG8_BAR; PG8_SCHED;
            PG8_STAGE(PG8_SB(1, 1), b3 + hstep, voffB);
            PG8_WAIT_V(6); PG8_BAR; PG8_MMA(1, 1, At, B1); PG8_BAR;
            }
        }
        if constexpr (ALIGN_EPI) { if (wr == 0) PG8_BAR; }
        if constexpr (!Epi::AFTER_DRAIN) { E(acc, cur, wr, wc, fr, fq); S.done(cur); }
        if (!has_next) break;
#pragma unroll
        for (int a = 0; a < 2; ++a)
#pragma unroll
            for (int b = 0; b < 2; ++b)
#pragma unroll
                for (int m = 0; m < 4; ++m)
#pragma unroll
                    for (int n = 0; n < 2; ++n) acc[a][b][m][n] = (f32x4){0.f, 0.f, 0.f, 0.f};
        cur = nxt; cA = nA; cB = nB; nt = cur.nt; ++ui;
        if constexpr (ALIGN_EPI) { if (wr == 1) PG8_BAR; }
    }
    PG8_WAIT_V(0);
    if constexpr (!ALIGN_EPI) { if (wr == 0) PG8_BAR; }
    PG8_BAR;
    if constexpr (Epi::AFTER_DRAIN) { E.fused(acc, cur, wr, wc, fr, fq, lds, wid, lane); S.done(cur); }
#undef PG8_SA
#undef PG8_SB
#undef PG8_STAGE
#undef PG8_LDA
#undef PG8_LDB
#undef PG8_MMA
#undef PG8_WAIT_V
#undef PG8_WAIT_L
#undef PG8_BAR
#undef PG8_SCHED
}
}

#define GAS __attribute__((address_space(1)))
typedef unsigned v4u __attribute__((ext_vector_type(4)));
typedef unsigned v2u __attribute__((ext_vector_type(2)));
typedef float f32x4 __attribute__((ext_vector_type(4)));
__device__ __forceinline__ unsigned pk2(float lo, float hi) { return (unsigned)f2bf(lo) | ((unsigned)f2bf(hi) << 16); }
__device__ __forceinline__ float wave_sum(float v) {
#pragma unroll
    for (int o = 1; o < 64; o <<= 1) v += __shfl_xor(v, o);
    return v;
}
#define XB_TMO      128
#define XB_XCNT(j)  (256  + 64 * (j))
#define XB_XSUB(j)  (1280 + 64 * (j))
#define XB_XGEN(j)  (2304 + 64 * (j))
#define XB_TOP      3328
#define XB_TOPGEN   3392
#define XCD_BAR_WORDS 3456
#define XB_SPIN_CAP (1u << 25)
#define LAS __attribute__((address_space(3)))

__device__ __forceinline__ unsigned xb_ld(unsigned* p)              { return __hip_atomic_load(p, __ATOMIC_RELAXED, __HIP_MEMORY_SCOPE_AGENT); }
__device__ __forceinline__ unsigned xb_add(unsigned* p, unsigned v) { return __hip_atomic_fetch_add(p, v, __ATOMIC_RELAXED, __HIP_MEMORY_SCOPE_AGENT); }
__device__ __forceinline__ unsigned xb_xcc_id() { return (unsigned)__builtin_amdgcn_s_getreg((3 << 11) | 20) & 0xFu; }
#define XB_SPIN(cond, bar) do { unsigned _sp = 0; while (cond) { __builtin_amdgcn_s_sleep(1); \
    if ((++_sp & 255u) == 0u) { if (xb_ld(&(bar)[XB_TMO])) break; if (_sp > XB_SPIN_CAP) { atomicAdd(&(bar)[XB_TMO], 1u); break; } } } } while (0)

struct XcdBarrier {
    unsigned* bar; unsigned x;
    volatile LAS unsigned* st;
};

__device__ __forceinline__ XcdBarrier xcd_barrier_post(unsigned* bar, volatile LAS unsigned* st) {
    XcdBarrier b; b.bar = bar; b.x = xb_xcc_id(); b.st = st;
    if (threadIdx.x == 0) (void)xb_add(&bar[XB_XCNT(b.x)], 1u);
    return b;
}
__device__ __forceinline__ void xcd_barrier_complete(unsigned* bar, unsigned x, unsigned& nloc, unsigned& nx) {
    const unsigned G = gridDim.x * gridDim.y * gridDim.z;
    unsigned sum, cnt, mine, sp = 0u;
    for (;;) {
        sum = 0u; cnt = 0u; mine = 0u;
#pragma unroll
        for (unsigned j = 0; j < 16; ++j) { const unsigned c = xb_ld(&bar[XB_XCNT(j)]); sum += c; cnt += (c > 0u) ? 1u : 0u; mine = (j == x) ? c : mine; }
        if (sum == G) break;
        __builtin_amdgcn_s_sleep(1);
        if ((++sp & 255u) == 0u) { if (xb_ld(&bar[XB_TMO])) break; if (sp > XB_SPIN_CAP) { atomicAdd(&bar[XB_TMO], 1u); break; } }
    }
    nloc = mine > 0u ? mine : 1u; nx = cnt > 0u ? cnt : 1u;
}

__device__ __forceinline__ void xcd_barrier(const XcdBarrier& b) {
    asm volatile("s_waitcnt vmcnt(0)" ::: "memory");
    __syncthreads();
    if (threadIdx.x == 0) {
        unsigned* bar = b.bar;
        __builtin_amdgcn_s_waitcnt(0);
        unsigned nloc = b.st[0], nx = b.st[1];
        if (nloc == 0u) { xcd_barrier_complete(bar, b.x, nloc, nx); b.st[0] = nloc; b.st[1] = nx; }
        const unsigned old = xb_add(&bar[XB_XSUB(b.x)], 1u);
        const unsigned gen = old / nloc;
        if (old + 1u == (gen + 1u) * nloc) {
            __builtin_amdgcn_fence(__ATOMIC_RELEASE, "agent");
            asm volatile("s_waitcnt vmcnt(0)" ::: "memory");
            const unsigned og = xb_add(&bar[XB_TOP], 1u);
            const unsigned tg = og / nx;
            if (og + 1u == (tg + 1u) * nx) xb_add(&bar[XB_TOPGEN], 1u);
            else XB_SPIN(xb_ld(&bar[XB_TOPGEN]) == tg, bar);
            __builtin_amdgcn_fence(__ATOMIC_ACQUIRE, "agent");
            xb_add(&bar[XB_XGEN(b.x)], 1u);
            asm volatile("s_waitcnt vmcnt(0)" ::: "memory");
        } else {
            XB_SPIN(xb_ld(&bar[XB_XGEN(b.x)]) == gen, bar);
            __builtin_amdgcn_fence(__ATOMIC_ACQUIRE, "agent");
            asm volatile("s_waitcnt vmcnt(0)" ::: "memory");
        }
    }
    __syncthreads();
}

#ifndef DUPMASK
#define DUPMASK 0
#endif
#define DUP(bit) for (int rep_ = 0; rep_ < ((DUPMASK & (bit)) ? 2 : 1); ++rep_)
constexpr int NWAVES = 8, NTHR = 512;
constexpr int LDS_STAGE = 131072;
constexpr int LDS_CTL = 163840 - 256;
constexpr int LDS_BYTES = 163840;
constexpr int CW_BAR = 4096;

__device__ __forceinline__ int fresh_tid() { int t = (int)threadIdx.x; asm volatile("" : "+v"(t)); return t; }
__device__ __forceinline__ int fresh_bid() { int b = (int)blockIdx.x; asm volatile("" : "+s"(b)); return b; }
__device__ __forceinline__ int fresh_vbid(int G) { const int b = fresh_bid(); return (G & 7) == 0 ? (b & 7) * (G >> 3) + (b >> 3) : b; }
struct Frame { LAS unsigned char* lds; int G; };
#define NAIVE_IDS() const long gid_ = (long)fresh_bid() * NTHR + fresh_tid(), nth_ = (long)F.G * NTHR
constexpr Dims mk_df() { Dims d = make_dims(2048, 8, 2048, 256, 4); d.rope_perm = 1; return d; }
constexpr Dims DF = mk_df();
constexpr size_t MiB = 1u << 20;
constexpr size_t rup(size_t b) { return (b + MiB - 1) / MiB * MiB; }
constexpr int H1F = DF.HS * 128, KTF = DF.S + DF.CTX;
constexpr int GDN_REC_BYTES = 74752;
constexpr size_t REC_TOTAL = (size_t)DF.B * DF.HS * 36 * 2 * GDN_REC_BYTES;
constexpr size_t WS_CTL = 0, WS_MODV = WS_CTL + MiB, WS_WTIN = WS_MODV + rup((size_t)DF.DEPTH * (DF.B + 1) * 6 * DF.D * 4), WS_WTOUT = WS_WTIN + rup((size_t)DF.NPE * DF.D * 2),
    WS_WTGU = WS_WTOUT + rup((size_t)DF.D * DF.D * 2), WS_WTDN = WS_WTGU + rup((size_t)2 * DF.FF * DF.D * 2), WS_H = WS_WTDN + rup((size_t)DF.D * DF.FF * 2),
    WS_PROJ = WS_H + rup((size_t)DF.M * DF.D * 4), WS_AB = WS_PROJ + rup((size_t)DF.M * DF.NPE * 2),
    WS_REC = WS_AB + rup((size_t)DF.M * DF.ABW * 4), WS_U = WS_REC,
    WS_DQB = WS_REC + rup(REC_TOTAL), WS_DKB = WS_DQB + rup((size_t)DF.M * H1F * 2), WS_DVT = WS_DKB + rup((size_t)DF.M * H1F * 2),
    WS_OGDN = WS_DVT + rup((size_t)DF.B * H1F * KTF * 2), WS_ODIFF = WS_OGDN + rup((size_t)2 * DF.M * H1F * 4), WS_END = WS_ODIFF + rup((size_t)2 * DF.M * H1F * 4);
static_assert(REC_TOTAL >= (size_t)DF.M * DF.D * 2 + (size_t)DF.B * 256 * KTF * 2, "u and the window V^T fit inside the record arena");
struct KArgs { const float* in[26]; float* out; unsigned char* ws; };
__device__ __forceinline__ Params mk_params(const KArgs& a) {
    unsigned char* ws = a.ws; asm volatile("" : "+s"(ws));
    Params P;
    P.x = a.in[0]; P.c = a.in[1]; P.ctx = a.in[2]; P.c_ctx = a.in[3]; P.ada_w = a.in[4]; P.ada_b = a.in[5]; P.norm_mix_g = a.in[6]; P.norm_ffn_g = a.in[7];
    P.w_in_even = a.in[8]; P.gdn_conv_w = a.in[9]; P.gdn_a_log = a.in[10]; P.gdn_dt_bias = a.in[11]; P.gdn_norm_g = a.in[12]; P.lq1 = a.in[13]; P.lk1 = a.in[14]; P.lq2 = a.in[15]; P.lk2 = a.in[16];
    P.subln_g = a.in[17]; P.w_in_odd = a.in[18]; P.na_rpb = a.in[19]; P.win_sink = a.in[20]; P.w_out = a.in[21]; P.ffn_wg = a.in[22]; P.ffn_wu = a.in[23]; P.ffn_wd = a.in[24]; P.final_g = a.in[25];
    P.out = a.out;
    P.rope32 = (float*)(ws + WS_CTL + 512 * 1024); P.rope64 = P.rope32 + 64 * 16 * 2;
    P.ctl = (unsigned*)(ws + WS_CTL); P.modv = (float*)(ws + WS_MODV); P.wt_in = (act_t*)(ws + WS_WTIN); P.wt_out = (act_t*)(ws + WS_WTOUT); P.wt_gu = (act_t*)(ws + WS_WTGU); P.wt_dn = (act_t*)(ws + WS_WTDN);
    P.h = (float*)(ws + WS_H); P.hb = (act_t*)(ws + WS_H); P.u = (act_t*)(ws + WS_U); P.y = P.u; P.proj = (act_t*)(ws + WS_PROJ); P.hid = P.proj; P.ab = (float*)(ws + WS_AB);
    P.qkvact = nullptr; P.gbuf = nullptr; P.betabuf = nullptr;
    P.dq_b = (act_t*)(ws + WS_DQB); P.dk_b = (act_t*)(ws + WS_DKB); P.dvT = (act_t*)(ws + WS_DVT); P.ogdn = (float*)(ws + WS_OGDN); P.odiff = (float*)(ws + WS_ODIFF);
    P.wq_b = P.dq_b; P.wk_b = P.dk_b; P.nvT = P.dvT; P.wvT = (act_t*)(ws + WS_REC + rup((size_t)DF.M * DF.D * 2));
    return P;
}

namespace att {
typedef short bf16x8 __attribute__((ext_vector_type(8)));
typedef short s16x4 __attribute__((ext_vector_type(4)));
typedef float f32x16 __attribute__((ext_vector_type(16)));
typedef float f32x4 __attribute__((ext_vector_type(4)));
typedef unsigned u32x4 __attribute__((ext_vector_type(4)));
typedef unsigned u32x2 __attribute__((ext_vector_type(2)));
typedef __bf16 bf2_t __attribute__((ext_vector_type(2)));
typedef float f2_t __attribute__((ext_vector_type(2)));
#define ATT_DI __device__ __forceinline__
ATT_DI unsigned pkbf(float a, float b) { f2_t v = {a, b}; bf2_t r = __builtin_convertvector(v, bf2_t); return __builtin_bit_cast(unsigned, r); }
constexpr float L2E = 1.4426950408889634f, NEG = -1.0e30f;
constexpr int VRS = 320, VBUF = 64 * VRS;
template <int DQK> struct Geo {
    static constexpr int KRS = DQK * 2 + 16, KBUF = 64 * KRS;
    static constexpr int KCH = DQK / 8, KPT = 64 * KCH / 512;
    static constexpr int TOTAL = 2 * KBUF + 3 * VBUF;
};
ATT_DI int simd_rank(LAS unsigned char* w4, int tid) {
    volatile LAS unsigned* c = (volatile LAS unsigned*)w4;
    asm volatile("s_waitcnt lgkmcnt(0)" ::: "memory"); __builtin_amdgcn_s_barrier(); asm volatile("" ::: "memory");
    if (tid < 4) c[tid] = 0u;
    asm volatile("s_waitcnt lgkmcnt(0)" ::: "memory"); __builtin_amdgcn_s_barrier(); asm volatile("" ::: "memory");
    const unsigned simd = __builtin_amdgcn_s_getreg((1 << 11) | (4 << 6) | 4) & 3u;
    unsigned rk = 0u; if ((tid & 63) == 0) rk = __hip_atomic_fetch_add((LAS unsigned*)w4 + simd, 1u, __ATOMIC_RELAXED, __HIP_MEMORY_SCOPE_WORKGROUP);
    rk = __builtin_amdgcn_readfirstlane(rk);
    asm volatile("s_waitcnt lgkmcnt(0)" ::: "memory"); __builtin_amdgcn_s_barrier(); asm volatile("" ::: "memory");
    return (int)(rk & 1u);
}
struct TileSrc { const bf16_t* k; int kstride; const bf16_t* v; int vstride; };

template <int DQK, class U> ATT_DI void run_unit(LAS unsigned char* lds, const U& u, int tid, int grp) {
    typedef Geo<DQK> G;
    const int lane = tid & 63, wave = __builtin_amdgcn_readfirstlane(tid >> 6), ql = lane & 31, h = lane >> 5;
    bf16x8 qf[DQK / 16];
    { const bf16_t* qp = u.qrow(wave, ql);
#pragma unroll
      for (int s = 0; s < DQK / 16; ++s) qf[s] = *(const bf16x8*)(qp + 16 * s + 8 * h); }
    f32x16 O[4];
#pragma unroll
    for (int t = 0; t < 4; ++t)
#pragma unroll
        for (int r = 0; r < 16; ++r) O[t][r] = 0.f;
    float m = u.m_init(wave, ql), l = h == 0 ? u.l_init(wave, ql) : 0.f;
    u32x4 kr[G::KPT], vr[2];
    const int nt = u.ntiles();
    auto gload = [&](int i) {
        const TileSrc t = u.tile(i);
#pragma unroll
        for (int c = 0; c < G::KPT; ++c) { const int cid = tid + 512 * c, row = cid / G::KCH, cc = cid % G::KCH; kr[c] = *(const u32x4*)(t.k + (size_t)row * t.kstride + cc * 8); }
#pragma unroll
        for (int c = 0; c < 2; ++c) { const int cid = tid + 512 * c, row = cid >> 4, cc = cid & 15; vr[c] = *(const u32x4*)(t.v + (size_t)row * t.vstride + cc * 8); }
    };
    auto lstore = [&](int b, int vslot) {
        LAS unsigned char* kb = lds + b * G::KBUF; LAS unsigned char* vb = lds + 2 * G::KBUF + vslot;
#pragma unroll
        for (int c = 0; c < G::KPT; ++c) { const int cid = tid + 512 * c, row = cid / G::KCH, cc = cid % G::KCH; *(LAS u32x4*)(kb + row * G::KRS + cc * 16) = kr[c]; }
#pragma unroll
        for (int c = 0; c < 2; ++c) { const int cid = tid + 512 * c, row = cid >> 4, cc = cid & 15; *(LAS u32x4*)(vb + row * VRS + cc * 16) = vr[c]; }
    };
    asm volatile("s_waitcnt lgkmcnt(0)" ::: "memory"); __builtin_amdgcn_s_barrier(); asm volatile("" ::: "memory");
    constexpr bool LATE = DQK == 64;
    bf16x8 pf[2][2];
    auto pv = [&](const LAS unsigned char* vb) {
        constexpr int PG = DQK == 64 ? 4 : 2;
        const int l16 = lane & 15;
        const LAS unsigned char* vp0 = vb + ((l16 >> 2) + 4 * h) * VRS + (16 * ((lane >> 4) & 1) + 4 * (l16 & 3)) * 2;
        s16x4 lo[PG], hi[PG], nlo[PG], nhi[PG];
#pragma unroll
        for (int k = 0; k < PG; ++k) { const int st = k, t = st >> 2, kt = (st >> 1) & 1, s2 = st & 1; const LAS unsigned char* vp = vp0 + (32 * kt + 16 * s2) * VRS + 64 * t;
            lo[k] = __builtin_amdgcn_ds_read_tr16_b64_v4i16((LAS s16x4*)vp); hi[k] = __builtin_amdgcn_ds_read_tr16_b64_v4i16((LAS s16x4*)(vp + 8 * VRS)); }
#pragma unroll
        for (int g = 0; g < 16 / PG; ++g) {
#pragma unroll
            for (int k = 0; k < PG; ++k) { nlo[k] = lo[k]; nhi[k] = hi[k]; }
            if (g + 1 < 16 / PG) {
#pragma unroll
                for (int k = 0; k < PG; ++k) { const int st = (g + 1) * PG + k, t = st >> 2, kt = (st >> 1) & 1, s2 = st & 1; const LAS unsigned char* vp = vp0 + (32 * kt + 16 * s2) * VRS + 64 * t;
                    nlo[k] = __builtin_amdgcn_ds_read_tr16_b64_v4i16((LAS s16x4*)vp); nhi[k] = __builtin_amdgcn_ds_read_tr16_b64_v4i16((LAS s16x4*)(vp + 8 * VRS)); } }
            __builtin_amdgcn_s_setprio(1);
#pragma unroll
            for (int k = 0; k < PG; ++k) { const int st = g * PG + k, t = st >> 2, kt = (st >> 1) & 1, s2 = st & 1;
                const bf16x8 av = {lo[k][0], lo[k][1], lo[k][2], lo[k][3], hi[k][0], hi[k][1], hi[k][2], hi[k][3]};
                O[t] = __builtin_amdgcn_mfma_f32_32x32x16_bf16(av, pf[kt][s2], O[t], 0, 0, 0); }
            __builtin_amdgcn_s_setprio(0);
#pragma unroll
            for (int k = 0; k < PG; ++k) { lo[k] = nlo[k]; hi[k] = nhi[k]; }
            __builtin_amdgcn_sched_barrier(0);
        }
    };
    auto qk_sm = [&](int i, const LAS unsigned char* kb) {
        f32x16 s0, s1;
#pragma unroll
        for (int r = 0; r < 16; ++r) { s0[r] = 0.f; s1[r] = 0.f; }
        {
            const LAS unsigned char* k0p = kb + ql * G::KRS + 16 * h; const LAS unsigned char* k1p = k0p + 32 * G::KRS;
            bf16x8 a0[2], a1[2], n0[2], n1[2];
#pragma unroll
            for (int k = 0; k < 2; ++k) { a0[k] = *(const LAS bf16x8*)(k0p + 32 * k); a1[k] = *(const LAS bf16x8*)(k1p + 32 * k); }
#pragma unroll
            for (int g = 0; g < DQK / 32; ++g) {
#pragma unroll
                for (int k = 0; k < 2; ++k) { n0[k] = a0[k]; n1[k] = a1[k]; }
                if (g + 1 < DQK / 32) {
#pragma unroll
                    for (int k = 0; k < 2; ++k) { n0[k] = *(const LAS bf16x8*)(k0p + 32 * (2 * g + 2 + k)); n1[k] = *(const LAS bf16x8*)(k1p + 32 * (2 * g + 2 + k)); } }
#pragma unroll
                for (int k = 0; k < 2; ++k) { s0 = __builtin_amdgcn_mfma_f32_32x32x16_bf16(a0[k], qf[2 * g + k], s0, 0, 0, 0); s1 = __builtin_amdgcn_mfma_f32_32x32x16_bf16(a1[k], qf[2 * g + k], s1, 0, 0, 0); }
#pragma unroll
                for (int k = 0; k < 2; ++k) { a0[k] = n0[k]; a1[k] = n1[k]; }
                __builtin_amdgcn_sched_barrier(0);
            }
        }
        u.scores(i, wave, ql, h, s0, s1);
        float mx = NEG;
#pragma unroll
        for (int r = 0; r < 16; ++r) mx = fmaxf(mx, fmaxf(s0[r], s1[r]));
        { const unsigned mu = __builtin_bit_cast(unsigned, mx); const auto sw = __builtin_amdgcn_permlane32_swap(mu, mu, false, false);
          mx = fmaxf(mx, __builtin_bit_cast(float, h ? sw[0] : sw[1])); }
        const float mn = mx > m + 8.0f ? mx : m, alpha = __builtin_amdgcn_exp2f(m - mn); m = mn;
        float ps = 0.f;
#pragma unroll
        for (int r = 0; r < 16; ++r) { s0[r] = __builtin_amdgcn_exp2f(s0[r] - mn); s1[r] = __builtin_amdgcn_exp2f(s1[r] - mn); ps += s0[r] + s1[r]; }
        l = l * alpha + ps;
        if (__any(alpha != 1.0f)) {
#pragma unroll
            for (int t = 0; t < 4; ++t)
#pragma unroll
                for (int r = 0; r < 16; ++r) O[t][r] *= alpha; }
#pragma unroll
        for (int s2 = 0; s2 < 2; ++s2) {
            u32x4 p0, p1;
            p0.x = pkbf(s0[8 * s2 + 0], s0[8 * s2 + 1]); p0.y = pkbf(s0[8 * s2 + 2], s0[8 * s2 + 3]); p0.z = pkbf(s0[8 * s2 + 4], s0[8 * s2 + 5]); p0.w = pkbf(s0[8 * s2 + 6], s0[8 * s2 + 7]);
            p1.x = pkbf(s1[8 * s2 + 0], s1[8 * s2 + 1]); p1.y = pkbf(s1[8 * s2 + 2], s1[8 * s2 + 3]); p1.z = pkbf(s1[8 * s2 + 4], s1[8 * s2 + 5]); p1.w = pkbf(s1[8 * s2 + 6], s1[8 * s2 + 7]);
            pf[0][s2] = __builtin_bit_cast(bf16x8, p0); pf[1][s2] = __builtin_bit_cast(bf16x8, p1);
        }
    };
    int vprev = 2 * VBUF, vcur = 0, vnext = VBUF; bool have = false;
    gload(0); if (LATE) { lstore(0, vcur); if (nt > 1) gload(1); }
    for (int i = 0; i < nt; ++i) {
        if (!LATE) lstore(i & 1, vcur);
        asm volatile("s_waitcnt lgkmcnt(0)" ::: "memory"); __builtin_amdgcn_s_barrier(); asm volatile("" ::: "memory");
        if (LATE) { if (i + 1 < nt) { lstore((i + 1) & 1, vnext); if (i + 2 < nt) gload(i + 2); } }
        else if (i + 1 < nt) gload(i + 1);
        const LAS unsigned char* vbase = lds + 2 * G::KBUF;
        if (grp && have) pv(vbase + vprev);
        have = u.uses(i, wave);
        if (have) { qk_sm(i, lds + (i & 1) * G::KBUF); if (!grp) pv(vbase + vcur); }
        { const int t = vprev; vprev = vcur; vcur = vnext; vnext = t; }
    }
    if (grp && have) pv(lds + 2 * G::KBUF + vprev);
    const float lt = l + __shfl_xor(l, 32);
    u.store(wave, ql, h, O, 1.0f / lt);
}

struct DiffU {
    const bf16_t *q, *k, *v; float* o;
    int b, head, c, qrow0, lat;
    bf16_t* y; const float* subg; float lam, outscale;
    ATT_DI int ntiles() const { return lat ? 36 : 4; }
    ATT_DI TileSrc tile(int i) const { const int ii = lat ? i : 32 + i; TileSrc t;
        const int krow = ii < 32 ? b * 2048 + 64 * ii : 16384 + b * 256 + 64 * (ii - 32);
        t.k = k + (size_t)krow * 7424 + head * 128 + c * 64; t.kstride = 7424;
        t.v = v + (size_t)krow * 7424 + head * 128; t.vstride = 7424; return t; }
    ATT_DI bool uses(int, int) const { return true; }
    ATT_DI const bf16_t* qrow(int wave, int ql) const { return q + (size_t)(qrow0 + 32 * wave + ql) * 7424 + head * 128 + c * 64; }
    ATT_DI float m_init(int, int) const { return NEG; }
    ATT_DI float l_init(int, int) const { return 0.f; }
    ATT_DI void scores(int, int, int, int, f32x16& s0, f32x16& s1) const {
#pragma unroll
        for (int r = 0; r < 16; ++r) { s0[r] *= 0.125f * L2E; s1[r] *= 0.125f * L2E; } }
    ATT_DI void store(int wave, int ql, int h, const f32x16 (&O)[4], float linv) const {
        const int row = qrow0 + 32 * wave + ql;
        float* op = o + (size_t)row * 1024 + head * 128 + 4 * h;
        if (c == 0) {
#pragma unroll
            for (int t = 0; t < 4; ++t)
#pragma unroll
                for (int g = 0; g < 4; ++g) { f32x4 v = {O[t][4 * g] * linv, O[t][4 * g + 1] * linv, O[t][4 * g + 2] * linv, O[t][4 * g + 3] * linv}; *(f32x4*)(op + 32 * t + 8 * g) = v; }
        } else {
            f32x4 d[4][4]; float ss = 0.f; const float ls = lam * linv;
#pragma unroll
            for (int t = 0; t < 4; ++t)
#pragma unroll
                for (int g = 0; g < 4; ++g) { const f32x4 o0 = *(const f32x4*)(op + 32 * t + 8 * g);
                    d[t][g] = (f32x4){o0[0] - ls * O[t][4 * g], o0[1] - ls * O[t][4 * g + 1], o0[2] - ls * O[t][4 * g + 2], o0[3] - ls * O[t][4 * g + 3]};
                    ss += (d[t][g][0] * d[t][g][0] + d[t][g][1] * d[t][g][1]) + (d[t][g][2] * d[t][g][2] + d[t][g][3] * d[t][g][3]); }
            ss += __shfl_xor(ss, 32);
            const float rn = outscale / sqrtf(ss * (1.0f / 128.f) + 1e-6f);
            bf16_t* yp = y + (size_t)row * 2048 + 1024 + head * 128 + 4 * h;
#pragma unroll
            for (int t = 0; t < 4; ++t)
#pragma unroll
                for (int g = 0; g < 4; ++g) { const f32x4 gg = *(const f32x4*)(subg + 32 * t + 8 * g + 4 * h);
                    *(u32x2*)(yp + 32 * t + 8 * g) = (u32x2){pkbf(d[t][g][0] * rn * gg[0], d[t][g][1] * rn * gg[1]), pkbf(d[t][g][2] * rn * gg[2], d[t][g][3] * rn * gg[3])}; }
        }
    }
};
struct NaU {
    const bf16_t *proj; bf16_t* y; const LAS float* rpb;
    int b, head, R, lat, lo, nloc;
    ATT_DI int ntiles() const { return lat ? nloc + 4 : 4; }
    ATT_DI TileSrc tile(int i) const { TileSrc t; const bool loc = lat && i < nloc; const int j = lat ? i - nloc : i;
        const int krow = loc ? b * 2048 + (lo + i) * 64 : 16384 + b * 256 + 64 * j;
        t.k = proj + (size_t)krow * 4608 + 1024 + head * 128; t.kstride = 4608; t.v = proj + (size_t)krow * 4608 + 2048 + head * 128; t.vstride = 4608; return t; }
    ATT_DI bool uses(int i, int wave) const { if (!lat || i >= nloc) return true; const int gr = lo + i, r = 4 * R + (wave >> 1), r0 = r - 4 < 0 ? 0 : (r - 4 > 24 ? 24 : r - 4); return gr >= r0 && gr <= r0 + 7; }
    ATT_DI int row_of(int wave, int ql) const { return (lat ? b * 2048 + 256 * R : 16384 + b * 256) + 32 * wave + ql; }
    ATT_DI const bf16_t* qrow(int wave, int ql) const { return proj + (size_t)row_of(wave, ql) * 4608 + head * 128; }
    ATT_DI float m_init(int, int) const { return NEG; }
    ATT_DI float l_init(int, int) const { return 0.f; }
    ATT_DI void scores(int i, int wave, int ql, int h, f32x16& s0, f32x16& s1) const {
        const float sc = 0.08838834764831845f * L2E;
        if (!lat || i >= nloc) {
#pragma unroll
            for (int r = 0; r < 16; ++r) { s0[r] *= sc; s1[r] *= sc; }
        } else {
            const int gr = lo + i, rq = 4 * R + (wave >> 1), c = 32 * (wave & 1) + ql, c0 = c - 8 < 0 ? 0 : (c - 8 > 48 ? 48 : c - 8);
            const LAS float* bp = rpb + (gr - rq + 7) * 31 - c + 15;
#pragma unroll
            for (int r = 0; r < 16; ++r) { const int kc = (r & 3) + 8 * (r >> 2) + 4 * h;
                s0[r] = (kc >= c0 && kc < c0 + 16) ? s0[r] * sc + bp[kc] : NEG;
                s1[r] = (kc + 32 >= c0 && kc + 32 < c0 + 16) ? s1[r] * sc + bp[kc + 32] : NEG; }
        }
    }
    ATT_DI void store(int wave, int ql, int h, const f32x16 (&O)[4], float linv) const {
        bf16_t* op = y + (size_t)row_of(wave, ql) * 2048 + head * 128 + 4 * h;
#pragma unroll
        for (int t = 0; t < 4; ++t)
#pragma unroll
            for (int g = 0; g < 4; ++g) { u32x2 v = {pkbf(O[t][4 * g] * linv, O[t][4 * g + 1] * linv), pkbf(O[t][4 * g + 2] * linv, O[t][4 * g + 3] * linv)}; *(u32x2*)(op + 32 * t + 8 * g) = v; }
    }
};
struct WinU {
    const bf16_t *q, *k, *v; bf16_t* y; const float* sink;
    int b, kvh, qb, lat, lo, nloc;
    ATT_DI int ntiles() const { return lat ? nloc + 4 : 4; }
    ATT_DI TileSrc tile(int i) const { TileSrc t; const bool loc = lat && i < nloc; const int j = lat ? i - nloc : i;
        const int krow = loc ? b * 2048 + (lo + i) * 64 : 16384 + b * 256 + 64 * j;
        t.k = k + (size_t)krow * 4608 + kvh * 128; t.kstride = 4608; t.v = v + (size_t)krow * 4608 + kvh * 128; t.vstride = 4608; return t; }
    ATT_DI bool uses(int, int) const { return true; }
    ATT_DI int row_of(int wave, int ql) const { return (lat ? b * 2048 : 16384 + b * 256) + 64 * qb + 32 * (wave & 1) + ql; }
    ATT_DI int head_of(int wave) const { return 4 * kvh + (wave >> 1); }
    ATT_DI const bf16_t* qrow(int wave, int ql) const { return q + (size_t)row_of(wave, ql) * 4608 + head_of(wave) * 128; }
    ATT_DI float m_init(int wave, int) const { return sink[head_of(wave)] * L2E; }
    ATT_DI float l_init(int, int) const { return 1.0f; }
    ATT_DI void scores(int i, int wave, int ql, int h, f32x16& s0, f32x16& s1) const {
        const float sc = 0.08838834764831845f * L2E;
        if (!lat || i >= nloc) {
#pragma unroll
            for (int r = 0; r < 16; ++r) { s0[r] *= sc; s1[r] *= sc; }
        } else {
            const int dq = 64 * qb + 32 * (wave & 1) + ql - (lo + i) * 64;
#pragma unroll
            for (int r = 0; r < 16; ++r) { const int kc = (r & 3) + 8 * (r >> 2) + 4 * h; const int d0 = dq - kc, d1 = dq - kc - 32;
                s0[r] = (d0 <= 128 && d0 >= -128) ? s0[r] * sc : NEG;
                s1[r] = (d1 <= 128 && d1 >= -128) ? s1[r] * sc : NEG; }
        }
    }
    ATT_DI void store(int wave, int ql, int h, const f32x16 (&O)[4], float linv) const {
        bf16_t* op = y + (size_t)row_of(wave, ql) * 2048 + 1024 + head_of(wave) * 128 + 4 * h;
#pragma unroll
        for (int t = 0; t < 4; ++t)
#pragma unroll
            for (int g = 0; g < 4; ++g) { u32x2 v = {pkbf(O[t][4 * g] * linv, O[t][4 * g + 1] * linv), pkbf(O[t][4 * g + 2] * linv, O[t][4 * g + 3] * linv)}; *(u32x2*)(op + 32 * t + 8 * g) = v; }
    }
};
}

namespace gdn {
using att::bf16x8; using att::s16x4; using att::f32x16; using att::f32x4; using att::u32x4; using att::u32x2; using att::pkbf;
#define GDN_DI __device__ __forceinline__
constexpr int REC_W = 0, REC_Q = 16384, REC_AT = 32768, REC_KT = 40960, REC_UT = 57344, REC_SC = 73728, REC_BYTES = 74752;
static_assert(REC_BYTES == GDN_REC_BYTES, "record size vs workspace map");
constexpr float SCALE = 0.08838834764831845f;
constexpr int L_KT = 0, L_VT = 18432, L_TAB = 36864, L_X = 38912;
constexpr int L_KR = L_X, L_QR = L_X + 17408, L_GM = L_X + 34816, L_QKM = L_GM + 16640;
constexpr int L_AT0 = L_KR, L_AT1 = L_QR;
constexpr int TRS = 192;
constexpr int L_TPT = L_GM, L_ATT = L_TPT + 4 * 64 * TRS, L_END = L_ATT + 2 * 9216;
static_assert(L_QKM + 16640 <= L_ATT && L_END <= 147200, "G1 LDS map");
constexpr int RS128 = 272, RS64 = 144;
GDN_DI int chunk_base(int b, int cix) { return cix < 4 ? 16384 + b * 256 + 64 * cix : b * 2048 + 64 * (cix - 4); }
GDN_DI size_t rec_off(int b, int h, int cix, int dir) { return (size_t)((((b * 8 + h) * 36 + cix) * 2) + dir) * REC_BYTES; }
GDN_DI unsigned rot16(unsigned x) { return (x >> 16) | (x << 16); }
GDN_DI void wg_bar() { asm volatile("s_waitcnt vmcnt(0) lgkmcnt(0)" ::: "memory"); __builtin_amdgcn_s_barrier(); asm volatile("" ::: "memory"); }
GDN_DI void lds_bar() { asm volatile("s_waitcnt lgkmcnt(0)" ::: "memory"); __builtin_amdgcn_s_barrier(); asm volatile("" ::: "memory"); }
GDN_DI bf16x8 tr_frag(const LAS unsigned char* blk, int stride, int lane) {
    const int l16 = lane & 15; const LAS unsigned char* p = blk + (l16 >> 2) * stride + (16 * ((lane >> 4) & 1) + 4 * (l16 & 3)) * 2;
    const s16x4 lo = __builtin_amdgcn_ds_read_tr16_b64_v4i16((LAS s16x4*)p), hi = __builtin_amdgcn_ds_read_tr16_b64_v4i16((LAS s16x4*)(p + 4 * stride));
    return (bf16x8){lo[0], lo[1], lo[2], lo[3], hi[0], hi[1], hi[2], hi[3]};
}

GDN_DI void g1_item(LAS unsigned char* lds, const bf16_t* proj  , const float* ab  , const float* conv_w  , const float* a_log, const float* dt_bias  ,
                    unsigned char* recs, int b, int h, int cix, int tid) {
    const int lane = tid & 63, wave = __builtin_amdgcn_readfirstlane(tid >> 6), r = lane & 31, hh = lane >> 5;
    const int base = chunk_base(b, cix), Tn = cix < 4 ? 256 : 2048, t0 = cix < 4 ? 64 * cix : 64 * (cix - 4);
    LAS float* tabG = (LAS float*)(lds + L_TAB); LAS float* tabB = tabG + 128; LAS float* gct = tabB + 128; LAS float* bt = gct + 128;
#pragma unroll
    for (int m = 0; m < 3; ++m)
#pragma unroll
        for (int c = 0; c < 2; ++c) {
            const int p = tid + 512 * c, i = p >> 4, grp = p & 15, t = t0 + i, col = m * 1024 + h * 128 + 8 * grp;
            const bf16_t* src = proj + (size_t)(base + i) * 7424 + col;
            const bf16x8 x0 = *(const bf16x8*)src; bf16x8 xm = {0, 0, 0, 0, 0, 0, 0, 0}, xp = {0, 0, 0, 0, 0, 0, 0, 0};
            if (t > 0) xm = *(const bf16x8*)(src - 7424);
            if (t < Tn - 1) xp = *(const bf16x8*)(src + 7424);
            const f32x4 w0a = *(const f32x4*)(conv_w + col), w0b = *(const f32x4*)(conv_w + col + 4), w1a = *(const f32x4*)(conv_w + 3072 + col), w1b = *(const f32x4*)(conv_w + 3072 + col + 4),
                        w2a = *(const f32x4*)(conv_w + 6144 + col), w2b = *(const f32x4*)(conv_w + 6144 + col + 4);
            float v[8]; float ss = 0.f;
#pragma unroll
            for (int e = 0; e < 8; ++e) { const float w0 = e < 4 ? w0a[e & 3] : w0b[e & 3], w1 = e < 4 ? w1a[e & 3] : w1b[e & 3], w2 = e < 4 ? w2a[e & 3] : w2b[e & 3];
                const float z = bf2f((bf16_t)xm[e]) * w0 + bf2f((bf16_t)x0[e]) * w1 + bf2f((bf16_t)xp[e]) * w2; v[e] = z / (1.0f + __expf(-z)); ss += v[e] * v[e]; }
            if (m < 2) { ss += __shfl_xor(ss, 1); ss += __shfl_xor(ss, 2); ss += __shfl_xor(ss, 4); ss += __shfl_xor(ss, 8); const float rn = 1.0f / sqrtf(ss + 1e-6f);
#pragma unroll
                for (int e = 0; e < 8; ++e) v[e] *= rn; }
            u32x4 pk; pk.x = pkbf(v[0], v[1]); pk.y = pkbf(v[2], v[3]); pk.z = pkbf(v[4], v[5]); pk.w = pkbf(v[6], v[7]);
            if (m == 0) *(LAS u32x4*)(lds + L_QR + i * RS128 + grp * 16) = pk;
            if (m == 1) *(LAS u32x4*)(lds + L_KR + i * RS128 + grp * 16) = pk;
            if (m >= 1) { LAS unsigned char* tb = lds + (m == 1 ? L_KT : L_VT) + (8 * grp) * RS64 + i * 2;
#pragma unroll
                for (int e = 0; e < 8; ++e) *(LAS bf16_t*)(tb + e * RS64) = f2bf(v[e]); }
        }
    if (tid < 128) { const int dir = tid >> 6, i = tid & 63; const float* abr = ab + (size_t)(base + i) * 32;
        const float a = abr[dir * 8 + h], bb = abr[16 + dir * 8 + h], x = a + dt_bias[dir * 8 + h];
        const float ex = __expf(x); const float sp = x > 20.f ? x : (ex < 1e-3f ? ex * (1.0f - 0.5f * ex) : __logf(1.0f + ex));
        tabG[dir * 64 + i] = -__expf(a_log[dir * 8 + h]) * sp; tabB[dir * 64 + i] = 1.0f / (1.0f + __expf(-bb)); }
    lds_bar();
#pragma unroll
    for (int k = 0; k < 2; ++k) { const int f = wave * 2 + k, rt = (f >> 3) & 1, ks = f & 7; const int tok = 32 * rt + r;
        const LAS unsigned char* p = lds + L_QR + tok * RS128 + (16 * ks + 4 * hh) * 2; const u32x2 lo = *(const LAS u32x2*)p, hi = *(const LAS u32x2*)(p + 16);
        *(u32x4*)(recs + rec_off(b, h, cix, 0) + REC_Q + (rt * 8 + ks) * 1024 + lane * 16) = (u32x4){lo.x, lo.y, hi.x, hi.y}; }
    { const int mat = wave >> 2, ti = (wave >> 1) & 1, tj = wave & 1;
      const LAS unsigned char* ap = lds + (mat ? L_QR : L_KR) + (32 * ti + r) * RS128 + 16 * hh; const LAS unsigned char* bp = lds + L_KR + (32 * tj + r) * RS128 + 16 * hh;
      f32x16 c; for (int q = 0; q < 16; ++q) c[q] = 0.f;
#pragma unroll
      for (int ks = 0; ks < 8; ++ks) c = __builtin_amdgcn_mfma_f32_32x32x16_bf16(*(const LAS bf16x8*)(ap + 32 * ks), *(const LAS bf16x8*)(bp + 32 * ks), c, 0, 0, 0);
      LAS float* dst = (LAS float*)(lds + (mat ? L_QKM : L_GM));
#pragma unroll
      for (int q = 0; q < 16; ++q) dst[(32 * ti + (q & 3) + 8 * (q >> 2) + 4 * hh) * 65 + 32 * tj + r] = c[q]; }
    if (wave < 2) { const int dir = wave, tok = dir ? 63 - lane : lane; float g = tabG[dir * 64 + tok];
#pragma unroll
        for (int o = 1; o < 64; o <<= 1) { const float y = __shfl_up(g, o); if (lane >= o) g += y; }
        gct[dir * 64 + lane] = g; bt[dir * 64 + lane] = tabB[dir * 64 + tok];
        const float gl = __shfl(g, 63);
        float* sc = (float*)(recs + rec_off(b, h, cix, dir) + REC_SC); sc[lane] = __expf(g) * SCALE; sc[64 + lane] = __expf(gl - g); if (lane == 0) sc[128] = __expf(gl); }
    lds_bar();
#pragma unroll
    for (int c = 0; c < 16; ++c) { const int idx = tid + 512 * c, dir = idx >> 12, ri = (idx >> 6) & 63, rj = idx & 63, i = dir ? 63 - ri : ri, j = dir ? 63 - rj : rj;
        const float dec = rj <= ri ? __expf(gct[dir * 64 + ri] - gct[dir * 64 + rj]) : 0.f;
        ((LAS float*)(lds + (dir ? L_AT1 : L_AT0)))[ri * 68 + rj] = rj < ri ? bt[dir * 64 + ri] * ((const LAS float*)(lds + L_GM))[i * 65 + j] * dec : 0.f;
        *(LAS bf16_t*)(lds + L_ATT + dir * 9216 + ri * RS64 + rj * 2) = f2bf(SCALE * ((const LAS float*)(lds + L_QKM))[i * 65 + j] * dec); }
    lds_bar();
    if ((wave & 3) == 0) { const int dir = wave >> 2; int ln = lane; asm volatile("" : "+v"(ln));
        typedef float f2v __attribute__((ext_vector_type(2)));
        const int blk = ln >> 5, c = ln & 31;
        const LAS float* Ad = (const LAS float*)(lds + (dir ? L_AT1 : L_AT0)); const LAS float* At = Ad + (32 * blk) * 68 + 32 * blk;
        f2v x2[16]; int off = 0;
#pragma unroll
        for (int i = 0; i < 32; ++i) { f2v acc2 = {(i == c) ? 1.0f : 0.0f, 0.0f};
#pragma unroll
            for (int j4 = 0; j4 < (i + 3) / 4; ++j4) { const f32x4 a4 = *(const LAS f32x4*)(At + off + i * 68 + 4 * j4);
                const f2v alo = {a4[0], a4[1]}, ahi = {a4[2], a4[3]};
                f2v xlo = x2[2 * j4], xhi = x2[2 * j4 + 1];
                if (4 * j4 + 0 >= i) xlo.x = 0.f; if (4 * j4 + 1 >= i) xlo.y = 0.f; if (4 * j4 + 2 >= i) xhi.x = 0.f; if (4 * j4 + 3 >= i) xhi.y = 0.f;
                acc2 -= alo * xlo; acc2 -= ahi * xhi; }
            const float acc = acc2.x + acc2.y;
            if (i & 1) x2[i >> 1].y = acc; else x2[i >> 1].x = acc;
            asm volatile("" : "+v"(off) : "v"(acc)); }
        float x[32];
#pragma unroll
        for (int i = 0; i < 32; ++i) x[i] = (i & 1) ? x2[i >> 1].y : x2[i >> 1].x;
        LAS unsigned char* img = lds + L_TPT + (2 * dir) * 64 * TRS;
        { const float b2 = bt[dir * 64 + ln], b1 = b2 * __expf(gct[dir * 64 + ln]); const int tokc = dir ? 63 - ln : ln;
          LAS unsigned char* tp = img + tokc * TRS; LAS unsigned char* tpp = tp + 64 * TRS;
#pragma unroll
          for (int q = 0; q < 4; ++q) {
              *(LAS u32x4*)(tp + 64 * blk + 16 * q) = (u32x4){pkbf(x[8 * q] * b1, x[8 * q + 1] * b1), pkbf(x[8 * q + 2] * b1, x[8 * q + 3] * b1), pkbf(x[8 * q + 4] * b1, x[8 * q + 5] * b1), pkbf(x[8 * q + 6] * b1, x[8 * q + 7] * b1)};
              *(LAS u32x4*)(tpp + 64 * blk + 16 * q) = (u32x4){pkbf(x[8 * q] * b2, x[8 * q + 1] * b2), pkbf(x[8 * q + 2] * b2, x[8 * q + 3] * b2), pkbf(x[8 * q + 4] * b2, x[8 * q + 5] * b2), pkbf(x[8 * q + 6] * b2, x[8 * q + 7] * b2)};
              *(LAS u32x4*)(img + ln * TRS + 128 + 16 * q) = (u32x4){pkbf(x[8 * q], x[8 * q + 1]), pkbf(x[8 * q + 2], x[8 * q + 3]), pkbf(x[8 * q + 4], x[8 * q + 5]), pkbf(x[8 * q + 6], x[8 * q + 7])}; }
          if (blk) {
#pragma unroll
              for (int q = 0; q < 4; ++q) { *(LAS u32x4*)(tp + 16 * q) = (u32x4){0u, 0u, 0u, 0u}; *(LAS u32x4*)(tpp + 16 * q) = (u32x4){0u, 0u, 0u, 0u}; } } }
        asm volatile("s_waitcnt lgkmcnt(0)" ::: "memory");
        const LAS unsigned char* xi = img + 128;
        f32x16 Pm; for (int q = 0; q < 16; ++q) Pm[q] = 0.f;
#pragma unroll
        for (int ks = 0; ks < 2; ++ks) { const LAS float* ar = Ad + (32 + r) * 68 + 16 * ks + 8 * hh; const f32x4 a0 = *(const LAS f32x4*)ar, a1 = *(const LAS f32x4*)(ar + 4);
            const bf16x8 af = __builtin_bit_cast(bf16x8, (u32x4){pkbf(a0[0], a0[1]), pkbf(a0[2], a0[3]), pkbf(a1[0], a1[1]), pkbf(a1[2], a1[3])});
            Pm = __builtin_amdgcn_mfma_f32_32x32x16_bf16(af, *(const LAS bf16x8*)(xi + r * TRS + (16 * ks + 8 * hh) * 2), Pm, 0, 0, 0); }
        f32x16 Tm; for (int q = 0; q < 16; ++q) Tm[q] = 0.f;
#pragma unroll
        for (int s = 0; s < 2; ++s) { const int l16 = lane & 15; const LAS unsigned char* p = xi + (32 + 16 * s + 4 * hh + (l16 >> 2)) * TRS + (16 * ((lane >> 4) & 1) + 4 * (l16 & 3)) * 2;
            const s16x4 lo = __builtin_amdgcn_ds_read_tr16_b64_v4i16((LAS s16x4*)p), hi = __builtin_amdgcn_ds_read_tr16_b64_v4i16((LAS s16x4*)(p + 8 * TRS));
            const bf16x8 af = (bf16x8){lo[0], lo[1], lo[2], lo[3], hi[0], hi[1], hi[2], hi[3]};
            const bf16x8 bfr = __builtin_bit_cast(bf16x8, (u32x4){pkbf(Pm[8 * s], Pm[8 * s + 1]), pkbf(Pm[8 * s + 2], Pm[8 * s + 3]), pkbf(Pm[8 * s + 4], Pm[8 * s + 5]), pkbf(Pm[8 * s + 6], Pm[8 * s + 7])});
            Tm = __builtin_amdgcn_mfma_f32_32x32x16_bf16(af, bfr, Tm, 0, 0, 0); }
        { const float b2 = -bt[dir * 64 + r], b1 = b2 * __expf(gct[dir * 64 + r]); const int tokc = dir ? 63 - r : r;
          LAS unsigned char* tp = img + tokc * TRS + (32 + 4 * hh) * 2; LAS unsigned char* tpp = tp + 64 * TRS;
#pragma unroll
          for (int g4 = 0; g4 < 4; ++g4) {
              *(LAS u32x2*)(tp + 16 * g4) = (u32x2){pkbf(Tm[4 * g4] * b1, Tm[4 * g4 + 1] * b1), pkbf(Tm[4 * g4 + 2] * b1, Tm[4 * g4 + 3] * b1)};
              *(LAS u32x2*)(tpp + 16 * g4) = (u32x2){pkbf(Tm[4 * g4] * b2, Tm[4 * g4 + 1] * b2), pkbf(Tm[4 * g4 + 2] * b2, Tm[4 * g4 + 3] * b2)}; } }
    }
    lds_bar();
#pragma unroll
    for (int k = 0; k < 2; ++k) { const int task = wave * 2 + k, dir = task >> 3, kind = (task >> 2) & 1, tl = task & 3;
        const LAS unsigned char* tim = lds + L_TPT + (2 * dir + kind) * 64 * TRS;
#pragma unroll
        for (int ti = 0; ti < 2; ++ti) { f32x16 c; for (int q = 0; q < 16; ++q) c[q] = 0.f;
            if (kind == 0) {
                const LAS unsigned char* ap = lds + L_KT + (32 * tl + r) * RS64 + 16 * hh;
#pragma unroll
                for (int ks = 0; ks < 4; ++ks) c = __builtin_amdgcn_mfma_f32_32x32x16_bf16(*(const LAS bf16x8*)(ap + 32 * ks), tr_frag(tim + (16 * ks + 8 * hh) * TRS + 64 * ti, TRS, lane), c, 0, 0, 0);
#pragma unroll
                for (int g = 0; g < 4; ++g) *(LAS u32x2*)(lds + (dir ? L_AT1 : L_AT0) + (32 * ti + r) * RS128 + (32 * tl + 8 * g + 4 * hh) * 2) = (u32x2){pkbf(c[4 * g], c[4 * g + 1]), pkbf(c[4 * g + 2], c[4 * g + 3])};
            } else {
                const LAS unsigned char* bp = lds + L_VT + (32 * tl + r) * RS64 + 16 * hh;
#pragma unroll
                for (int ks = 0; ks < 4; ++ks) c = __builtin_amdgcn_mfma_f32_32x32x16_bf16(tr_frag(tim + (16 * ks + 8 * hh) * TRS + 64 * ti, TRS, lane), *(const LAS bf16x8*)(bp + 32 * ks), c, 0, 0, 0);
                unsigned char* rec = recs + rec_off(b, h, cix, dir);
#pragma unroll
                for (int g = 0; g < 4; ++g) *(u32x2*)(rec + REC_UT + ((tl * 2 + ti) * 4 + g) * 512 + lane * 8) = (u32x2){pkbf(c[4 * g], c[4 * g + 1]), pkbf(c[4 * g + 2], c[4 * g + 3])};
            } }
    }
    lds_bar();
#pragma unroll
    for (int k = 0; k < 10; ++k) { const int ff = wave * 10 + k, dir = ff / 40, f = ff % 40; u32x2 lo, hi; unsigned char* dst; unsigned char* rec = recs + rec_off(b, h, cix, dir);
        if (f < 16) { const int rt = f >> 3, ks = f & 7; const LAS unsigned char* p = lds + (dir ? L_AT1 : L_AT0) + (32 * rt + r) * RS128 + (16 * ks + 4 * hh) * 2; lo = *(const LAS u32x2*)p; hi = *(const LAS u32x2*)(p + 16); dst = rec + REC_W + f * 1024; }
        else if (f < 24) { const int f2 = f - 16, rt = f2 >> 2, ks = f2 & 3; const LAS unsigned char* p = lds + L_ATT + dir * 9216 + (32 * rt + r) * RS64 + (16 * ks + 4 * hh) * 2; lo = *(const LAS u32x2*)p; hi = *(const LAS u32x2*)(p + 16); dst = rec + REC_AT + f2 * 1024; }
        else { if (dir == 1) continue;
            const int f2 = f - 24, kb = f2 >> 2, ks = f2 & 3; const LAS unsigned char* row = lds + L_KT + (32 * kb + r) * RS64;
            lo = *(const LAS u32x2*)(row + (16 * ks + 4 * hh) * 2); hi = *(const LAS u32x2*)(row + (16 * ks + 8 + 4 * hh) * 2);
            dst = rec + REC_KT + f2 * 1024; }
        *(u32x4*)(dst + lane * 16) = (u32x4){lo.x, lo.y, hi.x, hi.y}; }
    lds_bar();
}

constexpr int SB_UT = REC_UT, SB_SC = REC_UT + 8192, SB_BYTES = REC_UT + 8192 + 1024, SB_FRAGS = SB_BYTES / 1024;
GDN_DI int scan_cix(int dir, int n) { return dir == 0 ? n : (n < 4 ? 3 - n : 39 - n); }
GDN_DI void scan_load(LAS unsigned char* buf, const unsigned char* rec, const unsigned char* rec0, int dir, int sp, int lw  , int lane) {
    const int r = lane & 31, hh = lane >> 5;
#pragma unroll
    for (int k = 0; k < 17; ++k) { const int f = lw + 4 * k;
        if (f < SB_FRAGS) { const unsigned char* src;
            if (f >= 16 && f < 32) { const int f2 = f - 16, rt = f2 >> 3, ks = f2 & 7; src = dir ? rec0 + REC_Q + ((1 - rt) * 8 + ks) * 1024 + ((31 - r) + 32 * hh) * 16 : rec0 + REC_Q + f2 * 1024 + lane * 16; }
            else if (f >= 40 && f < 56) { const int f2 = f - 40, kb = f2 >> 2, ks = f2 & 3; src = dir ? rec0 + REC_KT + (kb * 4 + (3 - ks)) * 1024 + (r + 32 * (1 - hh)) * 16 : rec0 + REC_KT + f2 * 1024 + lane * 16; }
            else src = (f < 56 ? rec + f * 1024 : (f < 64 ? rec + REC_UT + sp * 8192 + (f - 56) * 1024 : rec + REC_SC)) + lane * 16;
            __builtin_amdgcn_global_load_lds((const unsigned*)src, (LAS unsigned*)(buf + f * 1024), 16, 0, 0); } }
}
constexpr int EX_S = 2 * SB_BYTES, EX_V = EX_S + 2 * 8192, EX_F = EX_V + 2 * 4096, EX_END = EX_F + 64;
static_assert(EX_END <= 163840 - 256, "scan LDS map");
GDN_DI void scan_wg(LAS unsigned char* lds, const unsigned char* recs, unsigned* og  , int b, int h, int dir, int sp, int tid) {
    const int lane = tid & 63, wave = __builtin_amdgcn_readfirstlane(tid >> 6), r = lane & 31, hh = lane >> 5, sl2 = wave & 1, sl = 2 * sp + sl2;
    f32x16 S[4];
#pragma unroll
    for (int k = 0; k < 4; ++k) for (int q = 0; q < 16; ++q) S[k][q] = 0.f;
    wg_bar();
    if (tid < 4) ((volatile LAS unsigned*)(lds + EX_F))[tid] = 0u;
    if (wave >= 4) scan_load(lds, recs + rec_off(b, h, scan_cix(dir, 0), dir), recs + rec_off(b, h, scan_cix(dir, 0), 0), dir, sp, wave - 4, lane);
    wg_bar();
    volatile LAS unsigned* fS = (volatile LAS unsigned*)(lds + EX_F) + sl2; volatile LAS unsigned* fV = fS + 2;
    LAS unsigned char* exs = lds + EX_S + sl2 * 8192 + lane * 16; LAS unsigned char* exv = lds + EX_V + sl2 * 4096 + lane * 16;
    for (int n = 0; n < 36; ++n) {
        LAS unsigned char* buf = lds + (n & 1) * SB_BYTES;
        const LAS float* sc = (const LAS float*)(buf + SB_SC);
        if (wave >= 4) { if (n + 1 < 36) scan_load(lds + ((n + 1) & 1) * SB_BYTES, recs + rec_off(b, h, scan_cix(dir, n + 1), dir), recs + rec_off(b, h, scan_cix(dir, n + 1), 0), dir, sp, wave - 4, lane); }
        else if (wave < 2) {
            const LAS unsigned char* fw = buf + REC_W + lane * 16; const LAS unsigned char* fk = buf + REC_KT + lane * 16;
            const LAS unsigned char* ut = buf + SB_UT + sl2 * 4096 + lane * 8;
            bf16x8 Sb[8];
#pragma unroll
            for (int kb = 0; kb < 4; ++kb)
#pragma unroll
                for (int s2 = 0; s2 < 2; ++s2) { u32x4 p; p.x = pkbf(S[kb][8 * s2], S[kb][8 * s2 + 1]); p.y = pkbf(S[kb][8 * s2 + 2], S[kb][8 * s2 + 3]); p.z = pkbf(S[kb][8 * s2 + 4], S[kb][8 * s2 + 5]); p.w = pkbf(S[kb][8 * s2 + 6], S[kb][8 * s2 + 7]);
                    Sb[2 * kb + s2] = __builtin_bit_cast(bf16x8, p); *(LAS u32x4*)(exs + (2 * kb + s2) * 1024) = p; }
            asm volatile("s_waitcnt lgkmcnt(0)" ::: "memory"); if (lane == 0) *fS = (unsigned)(n + 1);
            f32x16 X[2];
#pragma unroll
            for (int rt = 0; rt < 2; ++rt) { for (int q = 0; q < 16; ++q) X[rt][q] = 0.f;
#pragma unroll
                for (int ks = 0; ks < 8; ++ks) X[rt] = __builtin_amdgcn_mfma_f32_32x32x16_bf16(*(const LAS bf16x8*)(fw + (rt * 8 + ks) * 1024), Sb[ks], X[rt], 0, 0, 0); }
            bf16x8 veb[4];
#pragma unroll
            for (int rt = 0; rt < 2; ++rt)
#pragma unroll
                for (int s2 = 0; s2 < 2; ++s2) {
                    u32x4 pv, pe;
#pragma unroll
                    for (int gg = 0; gg < 2; ++gg) { const int g = 2 * s2 + gg;
                        const u32x2 uu = *(const LAS u32x2*)(ut + (rt * 4 + g) * 512);
                        const f32x4 ev = *(const LAS f32x4*)(sc + 64 + 32 * rt + 8 * g + 4 * hh);
                        const float u0 = __builtin_bit_cast(float, uu.x << 16), u1 = __builtin_bit_cast(float, uu.x & 0xffff0000u), u2 = __builtin_bit_cast(float, uu.y << 16), u3 = __builtin_bit_cast(float, uu.y & 0xffff0000u);
                        const float v0 = u0 - X[rt][4 * g], v1 = u1 - X[rt][4 * g + 1], v2 = u2 - X[rt][4 * g + 2], v3 = u3 - X[rt][4 * g + 3];
                        const unsigned a0 = pkbf(v0, v1), a1 = pkbf(v2, v3), e0 = pkbf(v0 * ev[0], v1 * ev[1]), e1 = pkbf(v2 * ev[2], v3 * ev[3]);
                        if (gg == 0) { pv.x = a0; pv.y = a1; pe.x = e0; pe.y = e1; } else { pv.z = a0; pv.w = a1; pe.z = e0; pe.w = e1; } }
                    *(LAS u32x4*)(exv + (2 * rt + s2) * 1024) = pv; veb[2 * rt + s2] = __builtin_bit_cast(bf16x8, pe); }
            asm volatile("s_waitcnt lgkmcnt(0)" ::: "memory"); if (lane == 0) *fV = (unsigned)(n + 1);
            const float gl = sc[128];
#pragma unroll
            for (int kb = 0; kb < 4; ++kb) {
#pragma unroll
                for (int q = 0; q < 16; ++q) S[kb][q] *= gl;
#pragma unroll
                for (int ks = 0; ks < 4; ++ks) { u32x4 kf = *(const LAS u32x4*)(fk + (kb * 4 + ks) * 1024);
                    if (dir) kf = (u32x4){rot16(kf.w), rot16(kf.z), rot16(kf.y), rot16(kf.x)};
                    S[kb] = __builtin_amdgcn_mfma_f32_32x32x16_bf16(__builtin_bit_cast(bf16x8, kf), veb[ks], S[kb], 0, 0, 0); }
            }
        } else {
            const int cix = scan_cix(dir, n);
            const LAS unsigned char* fq = buf + REC_Q + lane * 16; const LAS unsigned char* fa = buf + REC_AT + lane * 16;
            while (*fS != (unsigned)(n + 1)) __builtin_amdgcn_s_sleep(0);
            bf16x8 Sb[8];
#pragma unroll
            for (int f = 0; f < 8; ++f) Sb[f] = *(const LAS bf16x8*)(exs + f * 1024);
            f32x16 QS[2];
#pragma unroll
            for (int rt = 0; rt < 2; ++rt) { for (int q = 0; q < 16; ++q) QS[rt][q] = 0.f;
#pragma unroll
                for (int ks = 0; ks < 8; ++ks) QS[rt] = __builtin_amdgcn_mfma_f32_32x32x16_bf16(*(const LAS bf16x8*)(fq + (rt * 8 + ks) * 1024), Sb[ks], QS[rt], 0, 0, 0); }
#pragma unroll
            for (int rt = 0; rt < 2; ++rt)
#pragma unroll
                for (int g = 0; g < 4; ++g) { const f32x4 av = *(const LAS f32x4*)(sc + 32 * rt + 8 * g + 4 * hh);
                    QS[rt][4 * g] *= av[0]; QS[rt][4 * g + 1] *= av[1]; QS[rt][4 * g + 2] *= av[2]; QS[rt][4 * g + 3] *= av[3]; }
            while (*fV != (unsigned)(n + 1)) __builtin_amdgcn_s_sleep(0);
            bf16x8 vb[4];
#pragma unroll
            for (int f = 0; f < 4; ++f) vb[f] = *(const LAS bf16x8*)(exv + f * 1024);
            const int rbase = chunk_base(b, cix);
#pragma unroll
            for (int rt = 0; rt < 2; ++rt) {
#pragma unroll
                for (int ks = 0; ks < 4; ++ks) QS[rt] = __builtin_amdgcn_mfma_f32_32x32x16_bf16(*(const LAS bf16x8*)(fa + (rt * 4 + ks) * 1024), vb[ks], QS[rt], 0, 0, 0);
#pragma unroll
                for (int q = 0; q < 16; q += 2) { const int rho = 32 * rt + (q & 3) + 8 * (q >> 2) + 4 * hh, tev = dir ? 62 - rho : rho;
                    og[(size_t)((rbase + tev) >> 1) * 1024 + h * 128 + 32 * sl + r] = dir ? pkbf(QS[rt][q + 1], QS[rt][q]) : pkbf(QS[rt][q], QS[rt][q + 1]); }
            }
        }
        if (wave >= 4) asm volatile("s_waitcnt vmcnt(0) lgkmcnt(0)" ::: "memory"); else asm volatile("s_waitcnt lgkmcnt(0)" ::: "memory");
        __builtin_amdgcn_s_barrier(); asm volatile("" ::: "memory");
    }
}
}
__device__ __forceinline__ void wconv_item(const float* W, int K, int N, act_t* dst, const Dims& d, int kind, LAS float* scr, int item, int lane) {
    const int nblk = N / 32; const int kb = item / nblk, nb = item % nblk, k0 = 64 * kb, n0 = 32 * nb;
    float wv[32];
#pragma unroll
    for (int i = 0; i < 32; ++i) wv[i] = __builtin_nontemporal_load(&W[(size_t)(k0 + 2 * i + (lane >> 5)) * N + n0 + (lane & 31)]);
#pragma unroll
    for (int i = 0; i < 32; ++i) scr[(2 * i + (lane >> 5)) * 33 + (lane & 31)] = wv[i];
    asm volatile("s_waitcnt lgkmcnt(0)" ::: "memory");
    const int c = lane & 7;
#pragma unroll
    for (int j = 0; j < 4; ++j) { const int n = (lane >> 3) + 8 * j; const LAS float* s = scr + (8 * c) * 33 + n;
        v4u o; o.x = pk2(s[0 * 33], s[1 * 33]); o.y = pk2(s[2 * 33], s[3 * 33]); o.z = pk2(s[4 * 33], s[5 * 33]); o.w = pk2(s[6 * 33], s[7 * 33]);
        *(v4u*)(dst + (size_t)w_dstrow(d, kind, n0 + n) * K + k0 + 8 * c) = o; }
    asm volatile("s_waitcnt lgkmcnt(0)" ::: "memory");
}
template <int kind> __device__ __forceinline__ void ph_wconv(const Frame& F, const Params& P, const Dims& d, int layer) {
    const int tid = fresh_tid(), lane = tid & 63, wave = __builtin_amdgcn_readfirstlane(tid >> 6), bid = fresh_bid();
    LAS float* scr = (LAS float*)(F.lds + wave * 8448);
    const float* W; int K, N; act_t* dst; w_src(P, d, kind, layer, W, K, N, dst);
    const int nitems = (K / 64) * (N / 32);
    for (int item = bid * NWAVES + wave; item < nitems; item += F.G * NWAVES) wconv_item(W, K, N, dst, d, kind, scr, item, lane);
}
__device__ __forceinline__ void ph_wconv_queue(const Frame& F, const Params& P, const Dims& d, int layer, unsigned* ticket) {
    const int tid = fresh_tid(), lane = tid & 63, wave = __builtin_amdgcn_readfirstlane(tid >> 6);
    LAS float* scr = (LAS float*)(F.lds + wave * 8448); volatile LAS unsigned* tk = (volatile LAS unsigned*)(F.lds + 8 * 8448);
    const int nOut = (d.D / 64) * (d.D / 32), nGU = (d.D / 64) * (d.FF / 32), nDn = (d.FF / 64) * (d.D / 32), total = nOut + 2 * nGU + nDn;
    for (;;) {
        asm volatile("s_waitcnt lgkmcnt(0)" ::: "memory"); __builtin_amdgcn_s_barrier(); asm volatile("" ::: "memory");
        if (tid == 0) tk[0] = __hip_atomic_fetch_add(ticket, 8u, __ATOMIC_RELAXED, __HIP_MEMORY_SCOPE_AGENT);
        asm volatile("s_waitcnt vmcnt(0) lgkmcnt(0)" ::: "memory"); __builtin_amdgcn_s_barrier(); asm volatile("" ::: "memory");
        const int base = (int)tk[0]; if (base >= total) break;
        int it = base + wave; if (it >= total) continue;
        if (it < nOut) wconv_item(P.w_out + (size_t)layer * d.D * d.D, d.D, d.D, P.wt_out, d, WK_OUT, scr, it, lane);
        else if ((it -= nOut) < nGU) wconv_item(P.ffn_wg + (size_t)layer * d.D * d.FF, d.D, d.FF, P.wt_gu, d, WK_GATE, scr, it, lane);
        else if ((it -= nGU) < nGU) wconv_item(P.ffn_wu + (size_t)layer * d.D * d.FF, d.D, d.FF, P.wt_gu, d, WK_UP, scr, it, lane);
        else wconv_item(P.ffn_wd + (size_t)layer * d.FF * d.D, d.FF, d.D, P.wt_dn, d, WK_DOWN, scr, it - nGU, lane);
    }
}
__device__ __forceinline__ void ph_norm(const Frame& F, const Params& P, const Dims& d, int layer, int which, int nrows, const float* part = nullptr, int src0 = 0) {
    const int tid = fresh_tid(), lane = tid & 63, wave = __builtin_amdgcn_readfirstlane(tid >> 6), bid = fresh_bid();
    for (int row = bid * NWAVES + wave; row < nrows; row += F.G * NWAVES) {
        const float* hsrc = nullptr;
        if (src0 == 1 && row < d.ML) hsrc = P.x + (size_t)row * d.D;
        if (src0 >= 1 && row >= d.ML) hsrc = P.ctx + (size_t)(row - d.ML) * d.D;
        f32x4 v[8]; float ss = 0.f;
        if (hsrc != nullptr) { const f32x4* hr = (const f32x4*)hsrc + lane;
#pragma unroll
            for (int j = 0; j < 8; ++j) v[j] = hr[64 * j];
        } else { const v2u* hr = (const v2u*)(P.hb + (size_t)row * d.D) + lane;
#pragma unroll
            for (int j = 0; j < 8; ++j) { const v2u w = hr[64 * j];
                v[j] = (f32x4){__builtin_bit_cast(float, w.x << 16), __builtin_bit_cast(float, w.x & 0xffff0000u), __builtin_bit_cast(float, w.y << 16), __builtin_bit_cast(float, w.y & 0xffff0000u)}; } }
        if (part != nullptr && row >= d.ML) {
#pragma unroll
            for (int p4 = 0; p4 < 4; ++p4) { const v2u* pr = (const v2u*)((const bf16_t*)part + ((size_t)p4 * d.MC + (row - d.ML)) * d.D) + lane;
#pragma unroll
                for (int j = 0; j < 8; ++j) { const v2u w = pr[64 * j];
                    v[j] = v[j] + (f32x4){__builtin_bit_cast(float, w.x << 16), __builtin_bit_cast(float, w.x & 0xffff0000u), __builtin_bit_cast(float, w.y << 16), __builtin_bit_cast(float, w.y & 0xffff0000u)}; } }
            v2u* hw = (v2u*)(P.hb + (size_t)row * d.D) + lane;
#pragma unroll
            for (int j = 0; j < 8; ++j) hw[64 * j] = (v2u){pk2(v[j].x, v[j].y), pk2(v[j].z, v[j].w)};
        }
#pragma unroll
        for (int j = 0; j < 8; ++j) ss += (v[j].x * v[j].x + v[j].y * v[j].y) + (v[j].z * v[j].z + v[j].w * v[j].w);
        const float r = 1.0f / sqrtf(wave_sum(ss) / (float)d.D + 1e-6f);
        if (which == 2) {
            f32x4* o = (f32x4*)(P.out + (size_t)row * d.D) + lane; const f32x4* g = (const f32x4*)P.final_g + lane;
#pragma unroll
            for (int j = 0; j < 8; ++j) o[64 * j] = v[j] * r * g[64 * j];
        } else {
            const int b9 = row < d.ML ? row / d.S : d.B;
            const float* mv = P.modv + ((size_t)layer * (d.B + 1) + b9) * 6 * d.D;
            const f32x4* g = (const f32x4*)((which ? P.norm_ffn_g : P.norm_mix_g) + (size_t)layer * d.D) + lane;
            const f32x4* sh = (const f32x4*)(mv + (which ? 3 : 0) * d.D) + lane; const f32x4* sc = (const f32x4*)(mv + (which ? 4 : 1) * d.D) + lane;
            unsigned long long* o8 = (unsigned long long*)(P.u + (size_t)row * d.D) + lane;
#pragma unroll
            for (int j = 0; j < 8; ++j) { const f32x4 t = v[j] * r * g[64 * j] * (sc[64 * j] + 1.0f) + sh[64 * j];
                o8[64 * j] = (unsigned long long)pk2(t.x, t.y) | ((unsigned long long)pk2(t.z, t.w) << 32); }
        }
    }
}


__device__ __forceinline__ void ab_unit(const bf16_t* u, const bf16_t* wab  , float* ab, int rowtile, int tid) {
    const int lane = tid & 63, wave = __builtin_amdgcn_readfirstlane(tid >> 6), r = lane & 31, hh = lane >> 5;
    const bf16_t* ap = u + (size_t)(rowtile * 256 + wave * 32 + r) * 2048 + 8 * hh;
    const bf16_t* bp = wab + (size_t)r * 2048 + 8 * hh;
    att::f32x16 c; for (int q = 0; q < 16; ++q) c[q] = 0.f;
#pragma unroll 8
    for (int ks = 0; ks < 128; ++ks) c = __builtin_amdgcn_mfma_f32_32x32x16_bf16(*(const att::bf16x8*)(ap + 16 * ks), *(const att::bf16x8*)(bp + 16 * ks), c, 0, 0, 0);
    float* op = ab + (size_t)(rowtile * 256 + wave * 32) * 32 + r;
#pragma unroll
    for (int q = 0; q < 16; ++q) op[((q & 3) + 8 * (q >> 2) + 4 * hh) * 32] = c[q];
}
__device__ __forceinline__ void ph_mod(const Frame& F, const Params& P, const Dims& d, int l, unsigned* ticket) {
    const int tid = fresh_tid(), lane = tid & 63, wave = __builtin_amdgcn_readfirstlane(tid >> 6);
    LAS float* sil = (LAS float*)F.lds;
    LAS float* part = (LAS float*)(F.lds + 9 * 2048 * 4);
    volatile LAS unsigned* tk = (volatile LAS unsigned*)(F.lds + 9 * 2048 * 4 + 8 * 9 * 64 * 4);
    bool have_sil = false;
    for (;;) {
        asm volatile("s_waitcnt lgkmcnt(0)" ::: "memory"); __builtin_amdgcn_s_barrier(); asm volatile("" ::: "memory");
        if (tid == 0) tk[0] = __hip_atomic_fetch_add(ticket, 1u, __ATOMIC_RELAXED, __HIP_MEMORY_SCOPE_AGENT);
        asm volatile("s_waitcnt vmcnt(0) lgkmcnt(0)" ::: "memory"); __builtin_amdgcn_s_barrier(); asm volatile("" ::: "memory");
        const int it = (int)tk[0]; if (it >= 192) break;
        if (!have_sil) { have_sil = true;
            for (int i = tid; i < 9 * 2048; i += NTHR) { const int b9 = i >> 11, k = i & 2047; const float c = b9 < 8 ? P.c[b9 * 2048 + k] : P.c_ctx[k]; sil[i] = c / (1.0f + __expf(-c)); }
            asm volatile("s_waitcnt lgkmcnt(0)" ::: "memory"); __builtin_amdgcn_s_barrier(); asm volatile("" ::: "memory"); }
        const int n0 = it * 64;
        const float* w = P.ada_w + ((size_t)l * 2048 + 256 * wave) * 12288 + n0 + lane;
        float acc[9];
#pragma unroll
        for (int b = 0; b < 9; ++b) acc[b] = 0.f;
        float wa[16], wb[16]; const LAS float* sw = sil + 256 * wave;
#pragma unroll
        for (int i = 0; i < 16; ++i) wa[i] = __builtin_nontemporal_load(&w[(size_t)i * 12288]);
#pragma unroll 1
        for (int k0 = 0; k0 < 256; k0 += 32) {
#pragma unroll
            for (int i = 0; i < 16; ++i) wb[i] = __builtin_nontemporal_load(&w[(size_t)(k0 + 16 + i) * 12288]);
#pragma unroll
            for (int i = 0; i < 16; ++i) {
#pragma unroll
                for (int b = 0; b < 9; ++b) acc[b] += sw[b * 2048 + k0 + i] * wa[i]; }
            if (k0 + 32 < 256) {
#pragma unroll
                for (int i = 0; i < 16; ++i) wa[i] = __builtin_nontemporal_load(&w[(size_t)(k0 + 32 + i) * 12288]); }
#pragma unroll
            for (int i = 0; i < 16; ++i) {
#pragma unroll
                for (int b = 0; b < 9; ++b) acc[b] += sw[b * 2048 + k0 + 16 + i] * wb[i]; }
        }
#pragma unroll
        for (int b = 0; b < 9; ++b) part[(wave * 9 + b) * 64 + lane] = acc[b];
        asm volatile("s_waitcnt lgkmcnt(0)" ::: "memory"); __builtin_amdgcn_s_barrier(); asm volatile("" ::: "memory");
        for (int o = tid; o < 9 * 64; o += NTHR) { const int b = o >> 6, cl = o & 63; float s = P.ada_b[(size_t)l * 12288 + n0 + cl];
#pragma unroll
            for (int ks = 0; ks < 8; ++ks) s += part[(ks * 9 + b) * 64 + cl];
            P.modv[((size_t)l * 9 + b) * 12288 + n0 + cl] = s; }
    }
}
__device__ __forceinline__ void ph_merge_even(const Frame& F, const Params& P, const Dims& d, int layer, int nrows) {
    const int tid = fresh_tid(), lane = tid & 63, wave = __builtin_amdgcn_readfirstlane(tid >> 6), bid = fresh_bid();
    const int i2 = layer >> 1;
    typedef float f2 __attribute__((ext_vector_type(2)));
    const f2 gg = *(const f2*)(P.gdn_norm_g + i2 * 128 + 2 * lane);
    const unsigned* og0 = (const unsigned*)P.ogdn; const unsigned* og1 = og0 + (size_t)(d.M / 2) * 1024;
    for (int pair = bid * NWAVES + wave; pair < nrows / 2; pair += F.G * NWAVES) {
        const v2u* a0 = (const v2u*)(og0 + (size_t)pair * 1024) + lane; const v2u* a1 = (const v2u*)(og1 + (size_t)pair * 1024) + lane;
#pragma unroll
        for (int hs = 0; hs < 8; ++hs) {
            const v2u a = a0[hs * 64], b = a1[hs * 64];
#pragma unroll
            for (int rr = 0; rr < 2; ++rr) { const int row = 2 * pair + rr;
                const float ax = rr ? __builtin_bit_cast(float, a.x & 0xffff0000u) : __builtin_bit_cast(float, a.x << 16), ay = rr ? __builtin_bit_cast(float, a.y & 0xffff0000u) : __builtin_bit_cast(float, a.y << 16);
                const float bx = rr ? __builtin_bit_cast(float, b.x & 0xffff0000u) : __builtin_bit_cast(float, b.x << 16), by = rr ? __builtin_bit_cast(float, b.y & 0xffff0000u) : __builtin_bit_cast(float, b.y << 16);
                const f2 o = {ax + bx, ay + by};
                const float r = 1.0f / sqrtf(wave_sum(o.x * o.x + o.y * o.y) * (1.0f / 128.f) + 1e-6f);
                const bf16_t* zp = P.proj + (size_t)row * d.NPE + d.PZ + 2 * lane; bf16_t* yp = P.y + (size_t)row * 2048 + 2 * lane;
                const unsigned zz = *(const unsigned*)(zp + hs * 128); const float z0 = __builtin_bit_cast(float, zz << 16), z1 = __builtin_bit_cast(float, zz & 0xffff0000u);
                *(unsigned*)(yp + hs * 128) = pk2(o.x * r * gg.x * (z0 / (1.0f + __expf(-z0))), o.y * r * gg.y * (z1 / (1.0f + __expf(-z1)))); }
        }
    }
}

template <int V> struct IC { static constexpr int value = V; };
__global__ void __launch_bounds__(NTHR, 2) mk_fwd(KArgs KA) {
    constexpr Dims d = DF;
    extern __shared__ __attribute__((aligned(16))) unsigned char lds_raw[];
    Frame F; F.lds = (LAS unsigned char*)lds_raw; F.G = gridDim.x;
    for (int u = threadIdx.x; u < (LDS_BYTES - LDS_CTL) / 4; u += NTHR) ((LAS unsigned*)(F.lds + LDS_CTL))[u] = 0u;
    __syncthreads();
    const unsigned bar_x = xcd_barrier_post((unsigned*)(KA.ws + WS_CTL) + CW_BAR, (volatile LAS unsigned*)(F.lds + LDS_CTL)).x;
#define GRID_BAR() do { XcdBarrier b_; unsigned char* w_ = KA.ws; asm volatile("" : "+s"(w_)); unsigned x_ = bar_x; asm volatile("" : "+s"(x_)); \
        b_.bar = (unsigned*)(w_ + WS_CTL) + CW_BAR; b_.x = x_; b_.st = (volatile LAS unsigned*)(F.lds + LDS_CTL); xcd_barrier(b_); if (DUPMASK & 128) xcd_barrier(b_); } while (0)
    const int H1 = d.HS * 128; (void)H1;
    { const Params P = mk_params(KA); ph_mod(F, P, d, 0, P.ctl + 32768 + 64 * 8); }
    { const Params P = mk_params(KA); NAIVE_IDS(); st_rope_tab(P, d, 0, gid_, nth_); }
    GRID_BAR();
    auto layer_ = [&](auto LC_) {
        constexpr int l = decltype(LC_)::value;
        constexpr bool even = (l & 1) == 0, need_ctx = l < d.DEPTH - 1; const int Mr = need_ctx ? d.M : d.ML; const int NP = even ? d.NPE : d.NPO;
        DUP(2) {
        if (even) { ph_wconv<WK_IN_EVEN>(F, mk_params(KA), d, l); { const Params P = mk_params(KA); NAIVE_IDS(); st_wpad_even(P, d, l, gid_, nth_); } } else ph_wconv<WK_IN_ODD>(F, mk_params(KA), d, l);
        { const Params P = mk_params(KA); ph_norm(F, P, d, l, 0, d.M, l >= 1 ? P.ogdn : nullptr, l == 0 ? 1 : 0); }
        }
        GRID_BAR();
        { auto phB_ = [&]() { const Params P = mk_params(KA); pg8::Gemm g; g.A = P.u; g.Bt = P.wt_in; g.M = d.M; g.N = NP; g.K = d.D; pg8::StaticOrder S; S.init(g.M, g.N, F.G, fresh_bid(), g.K);
          pg8::EpiProj E; E.O = P.proj; E.ldc = NP; E.ab = P.ab; E.abw = d.ABW; E.ab_tile = even ? d.PA / 256 : -1;
          E.rope_lo = even ? d.PDQ / 256 : d.PWQ / 256; E.rope_hi = even ? d.PDV / 256 : d.PWV / 256; E.rope_n2 = even ? 16 : 32; E.rope_tab = even ? P.rope32 : P.rope64;
          pg8::gemm_phase<pg8::EpiProj, pg8::StaticOrder, true, true>(F.lds, g, S, E); };
          phB_(); if (DUPMASK & 64) phB_(); }
        { const Params P = mk_params(KA); ph_wconv_queue(F, P, d, l, P.ctl + 32768 + 64 * l); }
        GRID_BAR();
        if (even) {
            DUP(4) {
                const Params P = mk_params(KA); const int tid = fresh_tid(), bid = fresh_bid();
                for (int it = bid; it < 2304; it += F.G) { const int cix = it % 36, hh = (it / 36) & 7, bb = it / 288;
                    gdn::g1_item(F.lds, P.proj, P.ab, P.gdn_conv_w + (size_t)(l >> 1) * 9216, P.gdn_a_log + (l >> 1) * 16, P.gdn_dt_bias + (l >> 1) * 16, (unsigned char*)P.u, bb, hh, cix, tid); }
            }
            GRID_BAR();
            DUP(16) {
                const Params P = mk_params(KA); const int tid = fresh_tid(), bid = fresh_vbid(F.G);
                for (int task = bid; task < 256; task += F.G) { const int sp = task & 1, dir = (task >> 1) & 1, hh = (task >> 2) & 7, bb = task >> 5;
                    gdn::scan_wg(F.lds, (const unsigned char*)P.u, (unsigned*)P.ogdn + (size_t)dir * (d.M / 2) * 1024, bb, hh, dir, sp, tid); }
            }
            DUP(8) {
                const Params P = mk_params(KA); const int tid = fresh_tid(), bid = fresh_vbid(F.G); const int nu = 512 + (need_ctx ? 64 : 0);
                const float lam = diff_lambda(P, l), li = lambda_init_of(l); const int grp = att::simd_rank(F.lds + LDS_CTL + 64, tid);
                for (int ui = bid; ui < nu; ui += F.G) {
                    att::DiffU u; u.q = P.proj + d.PDQ; u.k = P.proj + d.PDK; u.v = P.proj + d.PDV; u.o = P.odiff; u.y = P.y; u.subg = P.subln_g + (l >> 1) * 128; u.lam = lam; u.outscale = 1.0f - li;
                    if (ui < 512) { const int qt = ui & 7; u.head = (ui >> 3) & 7; u.b = ui >> 6; u.qrow0 = u.b * 2048 + 256 * qt; u.lat = 1; }
                    else { const int j = ui - 512; u.head = j & 7; u.b = j >> 3; u.qrow0 = 16384 + u.b * 256; u.lat = 0; }
                    u.c = 0; att::run_unit<64>(F.lds, u, tid, grp);
                    u.c = 1; att::run_unit<64>(F.lds, u, tid, grp);
                }
            }
            GRID_BAR();
            DUP(1) ph_merge_even(F, mk_params(KA), d, l, Mr);
        } else {
            DUP(8) {
                const Params P = mk_params(KA); const int tid = fresh_tid(), bid = fresh_vbid(F.G); const int nu = 512 + (need_ctx ? 64 : 0);
                LAS float* rpb_l = (LAS float*)(F.lds + att::Geo<128>::TOTAL); const int grp = att::simd_rank(F.lds + LDS_CTL + 64, tid);
                for (int ui = bid; ui < nu; ui += F.G) {
                    att::NaU u; u.proj = P.proj; u.y = P.y; u.rpb = rpb_l;
                    if (ui < 512) { u.R = ui & 7; u.head = (ui >> 3) & 7; u.b = ui >> 6; u.lat = 1; const int a0 = 4 * u.R - 4, a1 = 4 * u.R - 1;
                        u.lo = a0 < 0 ? 0 : (a0 > 24 ? 24 : a0); u.nloc = (a1 < 0 ? 0 : (a1 > 24 ? 24 : a1)) + 7 - u.lo + 1; }
                    else { const int j = ui - 512; u.head = j & 7; u.b = j >> 3; u.R = 0; u.lat = 0; u.lo = 0; u.nloc = 0; }
                    asm volatile("s_waitcnt lgkmcnt(0)" ::: "memory"); __builtin_amdgcn_s_barrier(); asm volatile("" ::: "memory");
                    if (tid < 465) rpb_l[tid] = P.na_rpb[((size_t)(l >> 1) * 8 + u.head) * 465 + tid] * att::L2E;
                    att::run_unit<128>(F.lds, u, tid, grp);
                }
            }
            DUP(8) {
                const Params P = mk_params(KA); const int tid = fresh_tid(), bid = fresh_vbid(F.G); const int nu = 512 + (need_ctx ? 64 : 0); const int grp = att::simd_rank(F.lds + LDS_CTL + 64, tid);
                for (int ui = bid; ui < nu; ui += F.G) {
                    att::WinU u; u.q = P.proj + d.PWQ; u.k = P.proj + d.PWK; u.v = P.proj + d.PWV; u.y = P.y; u.sink = P.win_sink + (l >> 1) * 8;
                    if (ui < 512) { u.qb = ui & 31; u.kvh = (ui >> 5) & 1; u.b = ui >> 6; u.lat = 1; u.lo = u.qb - 2 < 0 ? 0 : u.qb - 2; const int hi = u.qb + 2 > 31 ? 31 : u.qb + 2; u.nloc = hi - u.lo + 1; }
                    else { const int j = ui - 512; u.qb = j & 3; u.kvh = (j >> 2) & 1; u.b = j >> 3; u.lat = 0; u.lo = 0; u.nloc = 0; }
                    att::run_unit<128>(F.lds, u, tid, grp);
                }
            }
        }
        GRID_BAR();
        { const Params P = mk_params(KA); pg8::Gemm g; g.A = P.y; g.Bt = P.wt_out; g.M = Mr; g.N = d.D; g.K = d.D; pg8::SplitOrder S; S.init(d.ML, Mr, g.N, F.G, fresh_bid(), g.K, 4);
          pg8::EpiResidT<l == 0> E; E.H = P.hb; E.Hin32 = P.x; E.ldc = d.D; E.gate0 = P.modv + (size_t)l * (d.B + 1) * 6 * d.D + 2 * d.D; E.S = d.S; E.ML = d.ML; E.B = d.B; E.D6 = 6 * d.D; E.part = P.ogdn;
          pg8::gemm_phase<pg8::EpiResidT<l == 0>, pg8::SplitOrder, true, true>(F.lds, g, S, E);
          if (DUPMASK & 256) { E.gate0 = (const float*)(P.ctl + 16384); E.D6 = 0; E.part = P.odiff; pg8::gemm_phase<pg8::EpiResidT<l == 0>, pg8::SplitOrder, true, true>(F.lds, g, S, E); } }
        GRID_BAR();
        { const Params P = mk_params(KA); ph_norm(F, P, d, l, 1, Mr, need_ctx ? P.ogdn : nullptr, l == 0 ? 2 : 0); }
        if (DUPMASK & 4096) { const Params P = mk_params(KA); ph_norm(F, P, d, l, 1, Mr, nullptr, 0); }
        GRID_BAR();
        { int fmode_ = 0; auto phF_ = [&]() { const Params P = mk_params(KA); pg8::Gemm g; g.A = P.u; g.Bt = P.wt_gu; g.M = Mr; g.N = 2 * d.FF; g.K = d.D; pg8::StaticOrder S; S.init(g.M, g.N, F.G, fresh_bid(), g.K);
          pg8::EpiSwiGLU E; E.O = P.hid; E.ldc = d.FF; E.mode = fmode_;
          pg8::gemm_phase<pg8::EpiSwiGLU, pg8::StaticOrder, true, true>(F.lds, g, S, E); };
          phF_(); if (DUPMASK & 32) phF_(); if (DUPMASK & 1024) { fmode_ = 1; phF_(); } if (DUPMASK & 2048) { fmode_ = 2; phF_(); } }
        if (l + 1 < d.DEPTH) { const Params P = mk_params(KA); ph_mod(F, P, d, l + 1, P.ctl + 32768 + 64 * (9 + l)); }
        GRID_BAR();
        { const Params P = mk_params(KA); pg8::Gemm g; g.A = P.hid; g.Bt = P.wt_dn; g.M = Mr; g.N = d.D; g.K = d.FF; pg8::SplitOrder S; S.init(d.ML, Mr, g.N, F.G, fresh_bid(), g.K, 4);
          pg8::EpiResidT<false> E; E.H = P.hb; E.Hin32 = nullptr; E.ldc = d.D; E.gate0 = P.modv + (size_t)l * (d.B + 1) * 6 * d.D + 5 * d.D; E.S = d.S; E.ML = d.ML; E.B = d.B; E.D6 = 6 * d.D; E.part = P.ogdn;
          pg8::gemm_phase<pg8::EpiResidT<false>, pg8::SplitOrder, true, true>(F.lds, g, S, E);
          if (DUPMASK & 512) { E.gate0 = (const float*)(P.ctl + 16384); E.D6 = 0; E.part = P.odiff; pg8::gemm_phase<pg8::EpiResidT<false>, pg8::SplitOrder, true, true>(F.lds, g, S, E); } }
        GRID_BAR();
    };
    layer_(IC<0>{}); layer_(IC<1>{}); layer_(IC<2>{}); layer_(IC<3>{});
    ph_norm(F, mk_params(KA), d, 0, 2, d.ML);
}

extern "C" void kernel_launch(void* const* d_in, const int* in_sizes, int n_in, void* d_out, int out_size, void* d_ws, size_t ws_size, hipStream_t stream) {
    static int grid = 0;
    if (WS_END > ws_size || n_in != 26) { fprintf(stderr, "kernel_launch: workspace too small (%zu needed, %zu given) or n_in %d != 26\n", (size_t)WS_END, ws_size, n_in); return; }
    KArgs a; memset(&a, 0, sizeof(a));
    for (int i = 0; i < 26; ++i) a.in[i] = (const float*)d_in[i];
    a.out = (float*)d_out; a.ws = (unsigned char*)d_ws;
    if (grid == 0) {
        int dev = 0, cus = 0, per_cu = 0;
        if (hipGetDevice(&dev) != hipSuccess || hipDeviceGetAttribute(&cus, hipDeviceAttributeMultiprocessorCount, dev) != hipSuccess) { fprintf(stderr, "kernel_launch: device query failed\n"); grid = -1; return; }
        if (hipFuncSetAttribute((const void*)mk_fwd, hipFuncAttributeMaxDynamicSharedMemorySize, LDS_BYTES) != hipSuccess) { fprintf(stderr, "kernel_launch: hipFuncSetAttribute failed\n"); grid = -1; return; }
        if (hipOccupancyMaxActiveBlocksPerMultiprocessor(&per_cu, (const void*)mk_fwd, NTHR, LDS_BYTES) != hipSuccess || per_cu < 1) { fprintf(stderr, "kernel_launch: occupancy query says %d blocks per CU\n", per_cu); }
        (void)hipGetLastError();
        grid = cus;
    }
    if (grid < 0) return;
    (void)hipMemsetAsync((unsigned char*)d_ws + WS_CTL, 0, 512 * 1024, stream);
    hipLaunchKernelGGL(mk_fwd, dim3(grid), dim3(NTHR), LDS_BYTES, stream, a);
}
#endif
```

```cpp
#include <cstdio>
#include <cstring>
#include <hip/hip_runtime.h>
#include <cmath>
#include <cstdint>

#define HD __host__ __device__ __forceinline__

typedef unsigned short bf16_t;
#ifdef ACT_F32
typedef float act_t;
HD float ldf(const float* p) { return *p; }
HD void stf(float* p, float v) { *p = v; }
#else
typedef bf16_t act_t;
#endif
HD float bf2f(bf16_t v) { return __builtin_bit_cast(float, ((unsigned)v) << 16); }
HD bf16_t f2bf(float f) { unsigned u = __builtin_bit_cast(unsigned, f); return (bf16_t)((u + 0x7fffu + ((u >> 16) & 1u)) >> 16); }
HD float ldf(const bf16_t* p) { return bf2f(*p); }
HD void stf(bf16_t* p, float v) { *p = f2bf(v); }

struct Dims {
    int D, B, S, CTX, FF, HS, DEPTH;
    int ML, MC, M;
    int NPE, NPO;
    int PQ, PK, PV, PZ, PDQ, PDK, PDV, PA, PB;
    int PNQ, PNK, PNV, PWQ, PWK, PWV;
    int ABW;
    int GR;
    int rope_perm;
};
HD constexpr Dims make_dims(int D, int B, int S, int CTX, int DEPTH) {
    Dims d{}; d.D = D; d.B = B; d.S = S; d.CTX = CTX; d.DEPTH = DEPTH; d.HS = D / 256;
    d.FF = ((8 * D + 3 * 256 - 1) / (3 * 256)) * 256;
    d.ML = B * S; d.MC = B * CTX; d.M = d.ML + d.MC;
    const int H1 = d.HS * 128;
    d.PQ = 0; d.PK = H1; d.PV = 2 * H1; d.PZ = 3 * H1; d.PDQ = 4 * H1; d.PDK = 5 * H1; d.PDV = 6 * H1; d.PA = 7 * H1; d.PB = 7 * H1 + 2 * d.HS;
    d.NPE = ((7 * H1 + 4 * d.HS + 255) / 256) * 256;
    d.PNQ = 0; d.PNK = H1; d.PNV = 2 * H1; d.PWQ = 3 * H1; d.PWK = 4 * H1; d.PWV = 4 * H1 + 256;
    d.NPO = ((4 * H1 + 512 + 255) / 256) * 256;
    d.ABW = 4 * d.HS; d.GR = S / 64; d.rope_perm = 0;
    return d;
}

struct Params {
    const float *x, *c, *ctx, *c_ctx, *ada_w, *ada_b, *norm_mix_g, *norm_ffn_g, *w_in_even, *gdn_conv_w, *gdn_a_log, *gdn_dt_bias, *gdn_norm_g,
                *lq1, *lk1, *lq2, *lk2, *subln_g, *w_in_odd, *na_rpb, *win_sink, *w_out, *ffn_wg, *ffn_wu, *ffn_wd, *final_g;
    float* out;
    unsigned* ctl;
    float* modv;
    act_t *wt_in, *wt_out, *wt_gu, *wt_dn;
    float* h;
    act_t* hb;
    act_t* u;
    act_t* proj;
    float* ab;
    act_t* y;
    act_t* hid;
    float *qkvact;
    float *gbuf, *betabuf;
    act_t *dq_b, *dk_b;
    act_t *dvT;
    act_t *nvT, *wvT;
    float *rope32, *rope64;
    act_t *wq_b, *wk_b;
    float *ogdn;
    float *odiff;
};

HD float silu_f(float x) { return x / (1.0f + expf(-x)); }
HD float sigmoid_f(float x) { return 1.0f / (1.0f + expf(-x)); }
HD float softplus_f(float x) { return x > 20.f ? x : log1pf(expf(x)); }
HD float lambda_init_of(int l) { return 0.8f - 0.6f * expf(-0.3f * (float)l); }

struct RowInfo { int lat, b, t, Tn, base; };
HD RowInfo row_info(const Dims& d, int row) {
    RowInfo r;
    if (row < d.ML) { r.lat = 1; r.b = row / d.S; r.t = row % d.S; r.Tn = d.S; r.base = r.b * d.S; }
    else { const int rr = row - d.ML; r.lat = 0; r.b = rr / d.CTX; r.t = rr % d.CTX; r.Tn = d.CTX; r.base = d.ML + r.b * d.CTX; }
    return r;
}

HD void st_mod(const Params& P, const Dims& d, int, long gid, long nth) {
    const long total = (long)d.DEPTH * (d.B + 1) * 6 * d.D;
    for (long i = gid; i < total; i += nth) {
        const int n = (int)(i % (6 * d.D)); const int b9 = (int)((i / (6 * d.D)) % (d.B + 1)); const int l = (int)(i / ((long)6 * d.D * (d.B + 1)));
        const float* cv = b9 < d.B ? P.c + (size_t)b9 * d.D : P.c_ctx;
        const float* w = P.ada_w + (size_t)l * d.D * 6 * d.D + n;
        float acc = 0.f;
        for (int k = 0; k < d.D; ++k) acc += silu_f(cv[k]) * w[(size_t)k * 6 * d.D];
        P.modv[i] = acc + P.ada_b[(size_t)l * 6 * d.D + n];
    }
}
HD void st_copy_h(const Params& P, const Dims& d, int, long gid, long nth) {
    const long nl = (long)d.ML * d.D, total = (long)d.M * d.D;
    for (long i = gid; i < total; i += nth) P.h[i] = i < nl ? P.x[i] : P.ctx[i - nl];
}
enum WKind { WK_IN_EVEN = 0, WK_IN_ODD = 1, WK_OUT = 2, WK_GATE = 3, WK_UP = 4, WK_DOWN = 5 };
HD int rope_il(int x, int n2) { return x < n2 ? 2 * x : 2 * (x - n2) + 1; }
HD int w_dstrow(const Dims& d, int kind, int j) {
    if (kind == WK_IN_EVEN) { const int H1 = d.HS * 128;
        if (j < 4 * H1) return j;
        if (j < 4 * H1 + 4 * d.HS) return d.PA + (j - 4 * H1);
        int o = j - 4 * H1 - 4 * d.HS;
        if (d.rope_perm && o < 2 * H1) o = (o & ~31) + rope_il(o & 31, 16);
        return d.PDQ + o; }
    if (kind == WK_IN_ODD) { const int H1 = d.HS * 128;
        if (d.rope_perm && j >= 3 * H1 && j < 4 * H1 + 256) return (j & ~63) + rope_il(j & 63, 32);
        return j; }
    if (kind == WK_GATE) return (j / 128) * 256 + (j % 128);
    if (kind == WK_UP) return (j / 128) * 256 + 128 + (j % 128);
    return j;
}
HD void w_src(const Params& P, const Dims& d, int kind, int layer, const float*& W, int& K, int& N, act_t*& dst) {
    const int i = layer / 2;
    switch (kind) {
        case WK_IN_EVEN: K = d.D; N = 7 * d.HS * 128 + 4 * d.HS; W = P.w_in_even + (size_t)i * K * N; dst = P.wt_in; break;
        case WK_IN_ODD:  K = d.D; N = 4 * d.HS * 128 + 512; W = P.w_in_odd + (size_t)i * K * N; dst = P.wt_in; break;
        case WK_OUT:     K = d.D; N = d.D; W = P.w_out + (size_t)layer * K * N; dst = P.wt_out; break;
        case WK_GATE:    K = d.D; N = d.FF; W = P.ffn_wg + (size_t)layer * K * N; dst = P.wt_gu; break;
        case WK_UP:      K = d.D; N = d.FF; W = P.ffn_wu + (size_t)layer * K * N; dst = P.wt_gu; break;
        default:         K = d.FF; N = d.D; W = P.ffn_wd + (size_t)layer * K * N; dst = P.wt_dn; break;
    }
}
HD void st_wconv(const Params& P, const Dims& d, int layer, int kind, long gid, long nth) {
    const float* W; int K, N; act_t* dst; w_src(P, d, kind, layer, W, K, N, dst);
    const long total = (long)K * N;
    for (long i = gid; i < total; i += nth) { const int k = (int)(i / N), j = (int)(i % N); stf(dst + (size_t)w_dstrow(d, kind, j) * K + k, W[i]); }
}
HD void st_wpad_even(const Params& P, const Dims& d, int, long gid, long nth) {
    const int r0 = d.PA + 4 * d.HS; const long total = (long)(d.NPE - r0) * d.D;
    for (long i = gid; i < total; i += nth) stf(P.wt_in + (size_t)r0 * d.D + i, 0.f);
}

HD void st_norm(const Params& P, const Dims& d, int layer, int which  , int nrows, long gid, long nth) {
    const float* g = (which ? P.norm_ffn_g : P.norm_mix_g) + (size_t)layer * d.D;
    for (long row = gid; row < nrows; row += nth) {
        const RowInfo ri = row_info(d, (int)row); const int b9 = ri.lat ? ri.b : d.B;
        const float* mv = P.modv + ((size_t)layer * (d.B + 1) + b9) * 6 * d.D;
        const float* shift = mv + (which ? 3 : 0) * d.D; const float* scale = mv + (which ? 4 : 1) * d.D;
        const float* hr = P.h + (size_t)row * d.D; float ss = 0.f;
        for (int k = 0; k < d.D; ++k) ss += hr[k] * hr[k];
        const float r = 1.0f / sqrtf(ss / (float)d.D + 1e-6f);
        for (int k = 0; k < d.D; ++k) stf(P.u + (size_t)row * d.D + k, hr[k] * r * g[k] * (1.0f + scale[k]) + shift[k]);
    }
}
HD void st_final_norm(const Params& P, const Dims& d, int, long gid, long nth) {
    for (long row = gid; row < d.ML; row += nth) {
        const float* hr = P.h + (size_t)row * d.D; float ss = 0.f;
        for (int k = 0; k < d.D; ++k) ss += hr[k] * hr[k];
        const float r = 1.0f / sqrtf(ss / (float)d.D + 1e-6f);
        for (int k = 0; k < d.D; ++k) P.out[(size_t)row * d.D + k] = hr[k] * r * P.final_g[k];
    }
}

HD void st_e_conv(const Params& P, const Dims& d, int layer, long gid, long nth) {
    const int C3 = 3 * d.HS * 128; const long total = (long)d.M * C3; const float* cw = P.gdn_conv_w + (size_t)(layer / 2) * 3 * C3;
    for (long i = gid; i < total; i += nth) {
        const int row = (int)(i / C3), ch = (int)(i % C3); const RowInfo ri = row_info(d, row);
        const act_t* p = P.proj + (size_t)row * d.NPE + ch;
        const float x0 = ldf(p), xm = ri.t > 0 ? ldf(p - d.NPE) : 0.f, xp = ri.t < ri.Tn - 1 ? ldf(p + d.NPE) : 0.f;
        P.qkvact[i] = silu_f(xm * cw[ch] + x0 * cw[C3 + ch] + xp * cw[2 * C3 + ch]);
    }
}
HD void st_e_l2(const Params& P, const Dims& d, int, long gid, long nth) {
    const int C3 = 3 * d.HS * 128; const long total = (long)d.M * 2 * d.HS;
    for (long i = gid; i < total; i += nth) {
        const int head = (int)(i % d.HS), which = (int)((i / d.HS) % 2), row = (int)(i / (2 * d.HS));
        float* p = P.qkvact + (size_t)row * C3 + which * d.HS * 128 + head * 128; float ss = 0.f;
        for (int e = 0; e < 128; ++e) ss += p[e] * p[e];
        const float r = 1.0f / sqrtf(ss + 1e-6f);
        for (int e = 0; e < 128; ++e) p[e] *= r;
    }
}
HD void st_e_gb(const Params& P, const Dims& d, int layer, long gid, long nth) {
    const long total = (long)d.M * 2 * d.HS; const int i2 = layer / 2;
    for (long i = gid; i < total; i += nth) {
        const int head = (int)(i % d.HS), dir = (int)((i / d.HS) % 2), row = (int)(i / (2 * d.HS));
        const float a = P.ab[(size_t)row * d.ABW + dir * d.HS + head], b = P.ab[(size_t)row * d.ABW + 2 * d.HS + dir * d.HS + head];
        const int pi = (i2 * 2 + dir) * d.HS + head;
        P.gbuf[i] = -expf(P.gdn_a_log[pi]) * softplus_f(a + P.gdn_dt_bias[pi]);
        P.betabuf[i] = sigmoid_f(b);
    }
}
HD float rope_inv(int i, int n) { return powf(10000.0f, -(float)(2 * i) / (float)n); }
HD void st_rope_tab(const Params& P, const Dims&, int, long gid, long nth) {
    for (long i = gid; i < 64 * 16 + 64 * 32; i += nth) {
        if (i < 64 * 16) { const int pos = (int)(i / 16), f = (int)(i % 16); const float ang = (float)pos * rope_inv(f, 32); P.rope32[2 * i] = cosf(ang); P.rope32[2 * i + 1] = sinf(ang); }
        else { const long k = i - 64 * 16; const int pos = (int)(k / 32), f = (int)(k % 32); const float ang = (float)pos * rope_inv(f, 64); P.rope64[2 * k] = cosf(ang); P.rope64[2 * k + 1] = sinf(ang); }
    }
}
HD void st_e_rope(const Params& P, const Dims& d, int, long gid, long nth) {
    const long total = (long)d.M * 2 * d.HS * 2 * 2 * 16;
    for (long idx = gid; idx < total; idx += nth) {
        long r = idx; const int i = (int)(r % 16); r /= 16; const int half = (int)(r % 2); r /= 2; const int comp = (int)(r % 2); r /= 2;
        const int head = (int)(r % d.HS); r /= d.HS; const int qk = (int)(r % 2); r /= 2; const int row = (int)r;
        const RowInfo ri = row_info(d, row);
        const int off = head * 128 + comp * 64 + half * 32;
        const act_t* src = P.proj + (size_t)row * d.NPE + (qk ? d.PDK : d.PDQ) + off;
        act_t* dst = (qk ? P.dk_b : P.dq_b) + (size_t)row * d.HS * 128 + off;
        const float x1 = ldf(src + i), x2 = ldf(src + 16 + i);
        if (ri.lat) { const int pos = half == 0 ? ri.t / 64 : ri.t % 64; const float cs = P.rope32[(pos * 16 + i) * 2], sn = P.rope32[(pos * 16 + i) * 2 + 1];
            stf(dst + i, x1 * cs - x2 * sn); stf(dst + 16 + i, x2 * cs + x1 * sn); }
        else { stf(dst + i, x1); stf(dst + 16 + i, x2); }
    }
}
HD void st_vT(const Params& P, const Dims& d, act_t* vT, int np, int col0, int nh, long gid, long nth) {
    const int KT = d.S + d.CTX; const long total = (long)d.B * nh * 128 * KT;
    for (long idx = gid; idx < total; idx += nth) {
        const int key = (int)(idx % KT); long r = idx / KT; const int e = (int)(r % 128); r /= 128; const int head = (int)(r % nh); const int b = (int)(r / nh);
        const int row = key < d.S ? b * d.S + key : d.ML + b * d.CTX + (key - d.S);
        vT[idx] = P.proj[(size_t)row * np + col0 + head * 128 + e];
    }
}
template <class PF> HD void st_e_gdn(const Params& P, const Dims& d, int, long gid, long nth, PF priv, int ps) {
    const int C3 = 3 * d.HS * 128; const long total = (long)d.B * 2 * d.HS * 128; const float scale = 0.08838834764831845f;
    for (long idx = gid; idx < total; idx += nth) {
        const int e = (int)(idx % 128), head = (int)((idx / 128) % d.HS), dir = (int)((idx / (128 * d.HS)) % 2), b = (int)(idx / (128 * d.HS * 2));
        for (int j = 0; j < 128; ++j) priv[j * ps] = 0.f;
        for (int ph = 0; ph < 2; ++ph) {
            const int Tn = ph == 0 ? d.CTX : d.S, base = ph == 0 ? d.ML + b * d.CTX : b * d.S;
            for (int step = 0; step < Tn; ++step) {
                const int row = base + (dir == 0 ? step : Tn - 1 - step);
                const float* q = P.qkvact + (size_t)row * C3 + head * 128; const float* k = q + d.HS * 128; const float ve = q[2 * d.HS * 128 + e];
                const float g = P.gbuf[((size_t)row * 2 + dir) * d.HS + head], beta = P.betabuf[((size_t)row * 2 + dir) * d.HS + head];
                const float dec = expf(g); float kv = 0.f;
#pragma unroll 8
                for (int j = 0; j < 128; ++j) { const float sj = priv[j * ps] * dec; priv[j * ps] = sj; kv += k[j] * sj; }
                const float vn = beta * (ve - kv); float o = 0.f;
#pragma unroll 8
                for (int j = 0; j < 128; ++j) { const float sj = priv[j * ps] + k[j] * vn; priv[j * ps] = sj; o += q[j] * sj; }
                P.ogdn[(((size_t)dir * d.M + row) * d.HS + head) * 128 + e] = o * scale;
            }
        }
    }
}
struct MS { float m, l; };
HD void ms_init(MS& a) { a.m = -INFINITY; a.l = 0.f; }
HD void ms_add(MS& a, float s) { const float mn = fmaxf(a.m, s); a.l = a.l * expf(a.m - mn) + expf(s - mn); a.m = mn; }
HD float diff_lambda(const Params& P, int layer) {
    const int i2 = layer / 2; float s1 = 0.f, s2 = 0.f;
    for (int j = 0; j < 64; ++j) { s1 += P.lq1[i2 * 64 + j] * P.lk1[i2 * 64 + j]; s2 += P.lq2[i2 * 64 + j] * P.lk2[i2 * 64 + j]; }
    return expf(s1) - expf(s2) + lambda_init_of(layer);
}
HD void st_e_diff(const Params& P, const Dims& d, int layer, int nrows, long gid, long nth) {
    const long total = (long)nrows * d.HS * 4; const int H1 = d.HS * 128;
    for (long idx = gid; idx < total; idx += nth) {
        const int row = (int)(idx % nrows); const int r2 = (int)(idx / nrows); const int eh = r2 % 2, c = (r2 / 2) % 2, head = r2 / 4;
        const RowInfo ri = row_info(d, row);
        float acc[64];
        const act_t* qp = P.dq_b + (size_t)row * H1 + head * 128 + c * 64;
#pragma unroll
        for (int j = 0; j < 64; ++j) acc[j] = 0.f;
        const int KT = d.S + d.CTX;
        MS a; ms_init(a);
        const int nseg = ri.lat ? 2 : 1;
        for (int pass = 0; pass < 2; ++pass)
            for (int seg = 0; seg < nseg; ++seg) {
                const int kb = (ri.lat && seg == 0) ? ri.b * d.S : d.ML + ri.b * d.CTX, kn = (ri.lat && seg == 0) ? d.S : d.CTX;
                for (int j = 0; j < kn; ++j) {
                    const act_t* kp = P.dk_b + (size_t)(kb + j) * H1 + head * 128 + c * 64; float t = 0.f;
#pragma unroll 8
                    for (int e = 0; e < 64; ++e) t += ldf(qp + e) * ldf(kp + e);
                    t *= 0.125f;
                    if (pass == 0) ms_add(a, t);
                    else { const float p = expf(t - a.m) / a.l;
                        const int key = (ri.lat && seg == 0) ? j : d.S + j;
                        const act_t* vp = P.dvT + ((size_t)(ri.b * d.HS + head) * 128 + eh * 64) * KT + key;
#pragma unroll
                        for (int e = 0; e < 64; ++e) acc[e] += p * ldf(vp + (size_t)e * KT); }
                }
            }
        float* op = P.odiff + ((size_t)c * d.M + row) * H1 + head * 128 + eh * 64;
#pragma unroll
        for (int e = 0; e < 64; ++e) op[e] = acc[e];
    }
}
HD void st_e_merge(const Params& P, const Dims& d, int layer, int nrows, long gid, long nth) {
    const int i2 = layer / 2, H1 = d.HS * 128; const long total = (long)nrows * 2 * d.HS; const float li = lambda_init_of(layer); const float lam = diff_lambda(P, layer);
    for (long idx = gid; idx < total; idx += nth) {
        const int hs = (int)(idx % (2 * d.HS)), row = (int)(idx / (2 * d.HS));
        if (hs < d.HS) {
            const float* o0 = P.ogdn + ((size_t)row * d.HS + hs) * 128; const float* o1 = o0 + (size_t)d.M * H1; float ss = 0.f;
            for (int e = 0; e < 128; ++e) { const float o = o0[e] + o1[e]; ss += o * o; }
            const float r = 1.0f / sqrtf(ss / 128.f + 1e-6f);
            for (int e = 0; e < 128; ++e) { const float z = ldf(P.proj + (size_t)row * d.NPE + d.PZ + hs * 128 + e);
                stf(P.y + (size_t)row * d.D + hs * 128 + e, (o0[e] + o1[e]) * r * P.gdn_norm_g[i2 * 128 + e] * silu_f(z)); }
        } else {
            const int hh = hs - d.HS; const float* o0 = P.odiff + (size_t)row * H1 + hh * 128; const float* o1 = o0 + (size_t)d.M * H1; float ss = 0.f;
            for (int e = 0; e < 128; ++e) { const float o = o0[e] - lam * o1[e]; ss += o * o; }
            const float r = 1.0f / sqrtf(ss / 128.f + 1e-6f);
            for (int e = 0; e < 128; ++e) stf(P.y + (size_t)row * d.D + H1 + hh * 128 + e, (o0[e] - lam * o1[e]) * r * P.subln_g[i2 * 128 + e] * (1.0f - li));
        }
    }
}

HD void st_o_rope(const Params& P, const Dims& d, int, long gid, long nth) {
    const int NS = d.HS + 2; const long total = (long)d.M * NS * 2 * 32;
    for (long idx = gid; idx < total; idx += nth) {
        long r = idx; const int i = (int)(r % 32); r /= 32; const int half = (int)(r % 2); r /= 2; const int slot = (int)(r % NS); r /= NS; const int row = (int)r;
        const RowInfo ri = row_info(d, row);
        const act_t* src = P.proj + (size_t)row * d.NPO + (slot < d.HS ? d.PWQ + slot * 128 : d.PWK + (slot - d.HS) * 128) + half * 64;
        act_t* dst = (slot < d.HS ? P.wq_b + ((size_t)row * d.HS + slot) * 128 : P.wk_b + ((size_t)row * 2 + (slot - d.HS)) * 128) + half * 64;
        const float x1 = ldf(src + i), x2 = ldf(src + 32 + i);
        if (ri.lat) { const int pos = half == 0 ? ri.t / 64 : ri.t % 64; const float cs = P.rope64[(pos * 32 + i) * 2], sn = P.rope64[(pos * 32 + i) * 2 + 1];
            stf(dst + i, x1 * cs - x2 * sn); stf(dst + 32 + i, x2 * cs + x1 * sn); }
        else { stf(dst + i, x1); stf(dst + 32 + i, x2); }
    }
}
HD int clampi(int v, int lo, int hi) { return v < lo ? lo : (v > hi ? hi : v); }
HD void st_o_na(const Params& P, const Dims& d, int layer, int nrows, long gid, long nth) {
    const int i2 = layer / 2; const long total = (long)nrows * d.HS * 4; const float scale = 0.08838834764831845f;
    for (long idx = gid; idx < total; idx += nth) {
        const int row = (int)(idx % nrows); const int r2 = (int)(idx / nrows); const int eq = r2 % 4, head = r2 / 4;
        const RowInfo ri = row_info(d, row);
        float acc[32];
        const act_t* qp = P.proj + (size_t)row * d.NPO + d.PNQ + head * 128;
#pragma unroll
        for (int j = 0; j < 32; ++j) acc[j] = 0.f;
        const int r = ri.t / 64, c = ri.t % 64;
        const int kr = d.GR < 8 ? d.GR : 8;
        const int r0 = clampi(r - kr / 2, 0, d.GR - kr), c0 = clampi(c - 8, 0, 64 - 16);
        const float* rpb = P.na_rpb + ((size_t)i2 * d.HS + head) * 15 * 31;
        const int nloc = ri.lat ? kr * 16 : 0;
        MS a; ms_init(a);
        for (int pass = 0; pass < 2; ++pass)
            for (int j = 0; j < nloc + d.CTX; ++j) {
                int krow; float bias = 0.f;
                if (j < nloc) { const int rr = r0 + j / 16, cc = c0 + j % 16; krow = ri.b * d.S + rr * 64 + cc; bias = rpb[(rr - r + 7) * 31 + (cc - c + 15)]; }
                else krow = d.ML + ri.b * d.CTX + (j - nloc);
                const act_t* kp = P.proj + (size_t)krow * d.NPO + d.PNK + head * 128; float t = 0.f;
#pragma unroll 8
                for (int e = 0; e < 128; ++e) t += ldf(qp + e) * ldf(kp + e);
                t = t * scale + bias;
                if (pass == 0) ms_add(a, t);
                else { const float p = expf(t - a.m) / a.l; const int KT = d.S + d.CTX; const int key = krow < d.ML ? krow - ri.b * d.S : d.S + (krow - d.ML - ri.b * d.CTX);
                    const act_t* vp = P.nvT + ((size_t)(ri.b * d.HS + head) * 128 + eq * 32) * KT + key;
#pragma unroll
                    for (int e = 0; e < 32; ++e) acc[e] += p * ldf(vp + (size_t)e * KT); }
            }
        act_t* op = P.y + (size_t)row * d.D + head * 128 + eq * 32;
#pragma unroll
        for (int e = 0; e < 32; ++e) stf(op + e, acc[e]);
    }
}
HD void st_o_win(const Params& P, const Dims& d, int layer, int nrows, long gid, long nth) {
    const int i2 = layer / 2; const long total = (long)nrows * d.HS * 4; const float scale = 0.08838834764831845f; const int grp = d.HS / 2;
    for (long idx = gid; idx < total; idx += nth) {
        const int row = (int)(idx % nrows); const int r2 = (int)(idx / nrows); const int eq = r2 % 4, head = r2 / 4;
        const RowInfo ri = row_info(d, row); const int kvh = head / grp;
        float acc[32];
        const act_t* qp = P.wq_b + ((size_t)row * d.HS + head) * 128;
#pragma unroll
        for (int j = 0; j < 32; ++j) acc[j] = 0.f;
        const int lo = ri.lat ? (ri.t - 128 < 0 ? 0 : ri.t - 128) : 0, hi = ri.lat ? (ri.t + 128 > d.S - 1 ? d.S - 1 : ri.t + 128) : -1;
        const int nloc = hi - lo + 1;
        const float sink = P.win_sink[i2 * d.HS + head];
        MS a; ms_init(a);
        for (int pass = 0; pass < 2; ++pass) {
            for (int j = 0; j < nloc + d.CTX; ++j) {
                const int krow = j < nloc ? ri.b * d.S + lo + j : d.ML + ri.b * d.CTX + (j - nloc);
                const act_t* kp = P.wk_b + ((size_t)krow * 2 + kvh) * 128; float t = 0.f;
#pragma unroll 8
                for (int e = 0; e < 128; ++e) t += ldf(qp + e) * ldf(kp + e);
                t *= scale;
                if (pass == 0) ms_add(a, t);
                else { const float p = expf(t - a.m) / a.l; const int KT = d.S + d.CTX; const int key = krow < d.ML ? krow - ri.b * d.S : d.S + (krow - d.ML - ri.b * d.CTX);
                    const act_t* vp = P.wvT + ((size_t)(ri.b * 2 + kvh) * 128 + eq * 32) * KT + key;
#pragma unroll
                    for (int e = 0; e < 32; ++e) acc[e] += p * ldf(vp + (size_t)e * KT); }
            }
            if (pass == 0) ms_add(a, sink);
        }
        act_t* op = P.y + (size_t)row * d.D + d.HS * 128 + head * 128 + eq * 32;
#pragma unroll
        for (int e = 0; e < 32; ++e) stf(op + e, acc[e]);
    }
}

HD const float* gate_vec(const Params& P, const Dims& d, int layer, int row, int chunk) {
    const RowInfo ri = row_info(d, row); const int b9 = ri.lat ? ri.b : d.B;
    return P.modv + ((size_t)layer * (d.B + 1) + b9) * 6 * d.D + (size_t)chunk * d.D;
}
#ifndef HOST_TEST
namespace pg8 {
#define PG8_LAS __attribute__((address_space(3)))
typedef unsigned short bf16_t;
typedef short bf16x8 __attribute__((ext_vector_type(8)));
typedef float f32x4 __attribute__((ext_vector_type(4)));
typedef unsigned u32x4 __attribute__((ext_vector_type(4)));
typedef unsigned u32x2 __attribute__((ext_vector_type(2)));
constexpr int BM = 256, BK = 64, HALF = 128, HTB = HALF * BK * 2  , STAGE_BYTES = 8 * HTB, NXCD = 8, WGM = 8;

__host__ __device__ __forceinline__ int lds_byte(int r, int c) { const int st = (r >> 4) * 2 + (c >> 5), rr = r & 15, cc = c & 31, ob = rr * 64 + cc * 2; return st * 1024 + (ob ^ (((ob >> 9) & 1) << 5)); }
__host__ __device__ __forceinline__ void stage_rc(int b, int& R, int& C) { const int st = b / 1024, sb = b % 1024, swz = sb ^ (((sb >> 9) & 1) << 5); R = (st >> 1) * 16 + swz / 64; C = (st & 1) * 32 + (swz % 64) / 2; }
__host__ __device__ __forceinline__ int perm32(int rho) { const int n = rho >> 4, i = rho & 15; return 8 * (i >> 2) + 4 * n + (i & 3); }

struct Unit { int pm, pn, kofs, nt, part; };
struct Gemm { const bf16_t* A; const bf16_t* Bt; int M, N, K; };

struct StaticOrder {
    int nM, nN, nwg, G, c, ntK;
    __host__ __device__ void init(int M, int N, int G_, int c_, int K = 0) { nM = M / BM; nN = N / BM; nwg = nM * nN; G = G_; c = c_; ntK = K / BK; }
    __host__ __device__ bool next(int i, Unit& u) const {
        const long L = (long)i * G + c; if (L >= nwg) return false;
        int wgid = (int)L; { const int q = nwg / NXCD, r = nwg % NXCD, xcd = wgid % NXCD, off = wgid / NXCD; wgid = (xcd < r ? xcd * (q + 1) : r * (q + 1) + (xcd - r) * q) + off; }
        const int nig = WGM * nN, gid = wgid / nig, fm = gid * WGM, gsz = (nM - fm) < WGM ? (nM - fm) : WGM;
        u.pm = fm + ((wgid % nig) % gsz); u.pn = (wgid % nig) / gsz; u.kofs = 0; u.nt = ntK; u.part = -1; return true;
    }
    __device__ __forceinline__ void a_ready(const Unit&) const {}
    __device__ __forceinline__ void done(const Unit&) const {}
};
struct SplitOrder {
    StaticOrder lat; int nlatu, nsplit, nN, pm0, ntq, kq_bytes;
    __host__ __device__ void init(int Mlat, int Mall, int N, int G_, int c_, int K, int parts) { lat.init(Mlat, N, G_, c_, K); nlatu = lat.nwg; nN = N / BM; pm0 = Mlat / BM;
        nsplit = ((Mall - Mlat) / BM) * nN * parts; ntq = K / BK / parts; kq_bytes = (K / parts) * 2; parts_ = parts; }
    int parts_;
    __host__ __device__ bool next(int i, Unit& u) const {
        const long L = (long)i * lat.G + lat.c;
        if (L < nlatu) return lat.next(i, u);
        const int e = (int)(L - nlatu); if (e >= nsplit) return false;
        const int tile = e / parts_, part = e % parts_, nrt = nsplit / parts_ / nN;
        u.pm = pm0 + tile % nrt; u.pn = tile / nrt; u.kofs = part * kq_bytes; u.nt = ntq; u.part = part; return true;
    }
    __device__ __forceinline__ void a_ready(const Unit&) const {}
    __device__ __forceinline__ void done(const Unit&) const {}
};
__device__ __forceinline__ unsigned cvt_pk_bf16(float lo, float hi) { unsigned r; asm volatile("v_cvt_pk_bf16_f32 %0, %1, %2" : "=v"(r) : "v"(lo), "v"(hi)); return r; }
struct EpiProj {
    static constexpr bool PERM = true, AFTER_DRAIN = false;
    bf16_t* O; int ldc; float* ab; int abw; int ab_tile;
    int rope_lo, rope_hi, rope_n2;
    const float* rope_tab;
    __device__ __forceinline__ void operator()(const f32x4 (&acc)[2][2][4][2], const Unit& u, int wr, int wc, int fr, int fq) const {
        const int row0 = u.pm * BM + wr * 64 + fr;
        if (u.pn == ab_tile) {
            if (wc == 0) {
#pragma unroll
                for (int ai = 0; ai < 2; ++ai)
#pragma unroll
                    for (int m = 0; m < 4; ++m) { float* p = ab + (size_t)(row0 + ai * HALF + m * 16) * abw + 8 * fq;
                        *(f32x4*)p = acc[ai][0][m][0]; *(f32x4*)(p + 4) = acc[ai][0][m][1]; }
            }
            return;
        }
        const int col0 = u.pn * BM + wc * 32 + 8 * fq;
        const bool rope = u.pn >= rope_lo && u.pn < rope_hi && u.pm < 64;
        const int axis = rope_n2 == 16 ? (wc & 1) : ((wc >> 1) & 1), j0 = rope_n2 == 16 ? 4 * fq : 16 * (wc & 1) + 4 * fq;
#pragma unroll
        for (int ai = 0; ai < 2; ++ai)
#pragma unroll
            for (int m = 0; m < 4; ++m) { const int row = row0 + ai * HALF + m * 16; bf16_t* rowp = O + (size_t)row * ldc + col0;
                f32x4 cs0 = {1.f, 0.f, 1.f, 0.f}, cs1 = cs0;
                if (rope) { const int t = row & 2047, pos = axis ? (t & 63) : (t >> 6); const float* tp = rope_tab + ((size_t)pos * rope_n2 + j0) * 2; cs0 = *(const f32x4*)tp; cs1 = *(const f32x4*)(tp + 4); }
#pragma unroll
                for (int bj = 0; bj < 2; ++bj) { f32x4 v0 = acc[ai][bj][m][0], v1 = acc[ai][bj][m][1];
                    if (rope) { v0 = (f32x4){v0[0] * cs0[0] - v0[1] * cs0[1], v0[1] * cs0[0] + v0[0] * cs0[1], v0[2] * cs0[2] - v0[3] * cs0[3], v0[3] * cs0[2] + v0[2] * cs0[3]};
                                v1 = (f32x4){v1[0] * cs1[0] - v1[1] * cs1[1], v1[1] * cs1[0] + v1[0] * cs1[1], v1[2] * cs1[2] - v1[3] * cs1[3], v1[3] * cs1[2] + v1[2] * cs1[3]}; }
                    u32x4 w; w.x = cvt_pk_bf16(v0[0], v0[1]); w.y = cvt_pk_bf16(v0[2], v0[3]); w.z = cvt_pk_bf16(v1[0], v1[1]); w.w = cvt_pk_bf16(v1[2], v1[3]);
                    *(u32x4*)(rowp + bj * HALF) = w; } }
    }
};
template <bool IN32> struct EpiResidT {
    static constexpr bool PERM = false, AFTER_DRAIN = false;
    bf16_t* H; const float* Hin32; int ldc; const float* gate0; int S, ML, B, D6;
    float* part;
    __device__ __forceinline__ void operator()(const f32x4 (&acc)[2][2][4][2], const Unit& u, int wr, int wc, int fr, int fq) const {
        const int r0t = u.pm * BM; const int b9 = r0t < ML ? r0t / S : B;
        const float* gate = gate0 + (size_t)b9 * D6;
        const int row0 = r0t + wr * 64 + fr, col0 = u.pn * BM + wc * 32 + 4 * fq;
        f32x4 gv[2][2];
#pragma unroll
        for (int bj = 0; bj < 2; ++bj)
#pragma unroll
            for (int n = 0; n < 2; ++n) gv[bj][n] = *(const f32x4*)(gate + col0 + bj * HALF + n * 16);
        if (u.part >= 0) {
            bf16_t* pb = (bf16_t*)part + ((size_t)u.part * (B * 256) + (row0 - ML)) * ldc + col0;
#pragma unroll
            for (int ai = 0; ai < 2; ++ai)
#pragma unroll
                for (int m = 0; m < 4; ++m) { bf16_t* rowp = pb + (size_t)(ai * HALF + m * 16) * ldc;
#pragma unroll
                    for (int bj = 0; bj < 2; ++bj)
#pragma unroll
                        for (int n = 0; n < 2; ++n) { const f32x4 t = gv[bj][n] * acc[ai][bj][m][n]; *(u32x2*)(rowp + bj * HALF + n * 16) = (u32x2){cvt_pk_bf16(t[0], t[1]), cvt_pk_bf16(t[2], t[3])}; } }
            return;
        }
#pragma unroll
        for (int ai = 0; ai < 2; ++ai)
#pragma unroll
            for (int m = 0; m < 4; ++m) { const size_t ro = (size_t)(row0 + ai * HALF + m * 16) * ldc + col0;
#pragma unroll
                for (int bj = 0; bj < 2; ++bj)
#pragma unroll
                    for (int n = 0; n < 2; ++n) { const int co = bj * HALF + n * 16; f32x4 hin;
                        if constexpr (IN32) hin = *(const f32x4*)(Hin32 + ro + co);
                        else { const u32x2 w = *(const u32x2*)(H + ro + co);
                            hin = (f32x4){__builtin_bit_cast(float, w.x << 16), __builtin_bit_cast(float, w.x & 0xffff0000u), __builtin_bit_cast(float, w.y << 16), __builtin_bit_cast(float, w.y & 0xffff0000u)}; }
                        const f32x4 t = hin + gv[bj][n] * acc[ai][bj][m][n];
                        *(u32x2*)(H + ro + co) = (u32x2){cvt_pk_bf16(t[0], t[1]), cvt_pk_bf16(t[2], t[3])}; } }
    }
};
struct EpiSwiGLU {
    static constexpr bool PERM = true, AFTER_DRAIN = false;
    bf16_t* O; int ldc; int mode;
    __device__ __forceinline__ void operator()(const f32x4 (&acc)[2][2][4][2], const Unit& u, int wr, int wc, int fr, int fq) const {
        if (mode == 2) {
            f32x4 s = acc[0][0][0][0];
#pragma unroll
            for (int ai = 0; ai < 2; ++ai)
#pragma unroll
                for (int bj = 0; bj < 2; ++bj)
#pragma unroll
                    for (int m = 0; m < 4; ++m)
#pragma unroll
                        for (int n = 0; n < 2; ++n) s = s + acc[ai][bj][m][n];
            if (s[0] + s[1] + s[2] + s[3] == 1.2345e33f) O[0] = 1;
            return; }
        const int row0 = u.pm * BM + wr * 64 + fr, col0 = u.pn * HALF + wc * 32 + 8 * fq;
#pragma unroll
        for (int ai = 0; ai < 2; ++ai)
#pragma unroll
            for (int m = 0; m < 4; ++m) { float o[8];
#pragma unroll
                for (int n = 0; n < 2; ++n)
#pragma unroll
                    for (int j = 0; j < 4; ++j) { const float g = acc[ai][0][m][n][j], up = acc[ai][1][m][n][j]; o[n * 4 + j] = g * __builtin_amdgcn_rcpf(1.0f + __expf(-g)) * up; }
                u32x4 w; w.x = cvt_pk_bf16(o[0], o[1]); w.y = cvt_pk_bf16(o[2], o[3]); w.z = cvt_pk_bf16(o[4], o[5]); w.w = cvt_pk_bf16(o[6], o[7]);
                if (mode == 0 || w.x == 0x12345678u) *(u32x4*)(O + (size_t)(row0 + ai * HALF + m * 16) * ldc + col0) = w; }
    }
};
template <class Epi, class Sched, bool ALIGN_EPI = false, bool SP2 = false>
__device__ __forceinline__ void gemm_phase(PG8_LAS unsigned char* lds, const Gemm g, const Sched& S, const Epi& E) {
    int tid = threadIdx.x; asm volatile("" : "+v"(tid)); const int wid = __builtin_amdgcn_readfirstlane(tid >> 6), lane = tid & 63, wr = wid >> 2, wc = wid & 3, fr = lane & 15, fq = lane >> 4;
    const int K = g.K;
    unsigned voffA[2], voffB[2];
#pragma unroll
    for (int i = 0; i < 2; ++i) { int R, C; stage_rc(tid * 16 + i * 8192, R, C); const int Rb = Epi::PERM ? ((R & ~31) + perm32(R & 31)) : R;
        voffA[i] = (unsigned)(R * K + C) * 2u; voffB[i] = (unsigned)(Rb * K + C) * 2u; }
    const size_t kstep = (size_t)(BK * 2);
    const size_t hstep = (size_t)HALF * K * 2;
    const size_t tstep = 2 * hstep;
    const unsigned ldsw = (unsigned)wid * 1024u;
    const int aoff = lds_byte(wr * 64 + fr, fq * 8), boff = lds_byte(wc * 32 + fr, fq * 8);
#define PG8_SA(b, h) (((b) * 2 + (h)) * HTB)
#define PG8_SB(b, h) ((4 + (b) * 2 + (h)) * HTB)
#define PG8_STAGE(bufoff, gbase, voff) do { _Pragma("unroll") for (int _i = 0; _i < 2; ++_i) \
        __builtin_amdgcn_global_load_lds((const unsigned*)((const char*)(gbase) + (voff)[_i]), (PG8_LAS unsigned*)(lds + (bufoff) + ldsw + _i * 8192), 16, 0, 0); } while (0)
#define PG8_LDA(dst, b, h) do { _Pragma("unroll") for (int m = 0; m < 4; ++m) _Pragma("unroll") for (int k = 0; k < 2; ++k) dst[m][k] = *(const PG8_LAS bf16x8*)(lds + PG8_SA(b, h) + aoff + m * 2048 + k * 1024); } while (0)
#define PG8_LDB(dst, b, h) do { _Pragma("unroll") for (int n = 0; n < 2; ++n) _Pragma("unroll") for (int k = 0; k < 2; ++k) dst[n][k] = *(const PG8_LAS bf16x8*)(lds + PG8_SB(b, h) + boff + n * 2048 + k * 1024); } while (0)
#define PG8_MMA(ai, bj, At, Bt) do { __builtin_amdgcn_s_setprio(1); _Pragma("unroll") for (int m = 0; m < 4; ++m) _Pragma("unroll") for (int n = 0; n < 2; ++n) _Pragma("unroll") for (int k = 0; k < 2; ++k) \
        acc[ai][bj][m][n] = __builtin_amdgcn_mfma_f32_16x16x32_bf16(Bt[n][k], At[m][k], acc[ai][bj][m][n], 0, 0, 0); __builtin_amdgcn_s_setprio(0); } while (0)
#define PG8_WAIT_V(n) asm volatile("s_waitcnt vmcnt(" #n ")" ::: "memory")
#define PG8_WAIT_L(n) asm volatile("s_waitcnt lgkmcnt(" #n ")" ::: "memory")
#define PG8_BAR __builtin_amdgcn_s_barrier()
#define PG8_SCHED __builtin_amdgcn_sched_barrier(0)
    Unit cur, nxt; int ui = 0;
    if (!S.next(0, cur)) return;
    f32x4 acc[2][2][4][2];
#pragma unroll
    for (int a = 0; a < 2; ++a)
#pragma unroll
        for (int b = 0; b < 2; ++b)
#pragma unroll
            for (int m = 0; m < 4; ++m)
#pragma unroll
                for (int n = 0; n < 2; ++n) acc[a][b][m][n] = (f32x4){0.f, 0.f, 0.f, 0.f};
    bf16x8 At[4][2], B0[2][2], B1[2][2];
    const char* cA = (const char*)g.A + (size_t)cur.pm * tstep + cur.kofs; const char* cB = (const char*)g.Bt + (size_t)cur.pn * tstep + cur.kofs; int nt = cur.nt;
    S.a_ready(cur);
    if constexpr (SP2) {
        PG8_STAGE(PG8_SB(0, 0), cB, voffB); PG8_STAGE(PG8_SB(0, 1), cB + hstep, voffB); PG8_STAGE(PG8_SA(0, 0), cA, voffA); PG8_STAGE(PG8_SA(0, 1), cA + hstep, voffA);
        if (wr == 1) PG8_BAR;
        PG8_WAIT_V(2); PG8_BAR;
        PG8_STAGE(PG8_SB(1, 0), cB + kstep, voffB); PG8_STAGE(PG8_SA(1, 0), cA + kstep, voffA); PG8_STAGE(PG8_SB(1, 1), cB + hstep + kstep, voffB);
        PG8_WAIT_V(6); PG8_BAR;
    } else {
        PG8_STAGE(PG8_SB(0, 0), cB, voffB); PG8_STAGE(PG8_SA(0, 0), cA, voffA); PG8_STAGE(PG8_SB(0, 1), cB + hstep, voffB); PG8_STAGE(PG8_SA(0, 1), cA + hstep, voffA);
        if (wr == 1) PG8_BAR;
        PG8_WAIT_V(4); PG8_BAR;
        PG8_STAGE(PG8_SB(1, 0), cB + kstep, voffB); PG8_STAGE(PG8_SA(1, 0), cA + kstep, voffA); PG8_STAGE(PG8_SB(1, 1), cB + hstep + kstep, voffB);
        PG8_WAIT_V(6); PG8_BAR;
    }
    for (;;) {
        const bool has_next = S.next(ui + 1, nxt);
        const char* nA = has_next ? (const char*)g.A + (size_t)nxt.pm * tstep + nxt.kofs : cA; const char* nB = has_next ? (const char*)g.Bt + (size_t)nxt.pn * tstep + nxt.kofs : cB;
        for (int t = 0; t < nt; t += 2) {
            const bool last = (t == nt - 2);
            const char* a1 = cA + (size_t)(t + 1) * kstep;
            const char* a2 = last ? nA : cA + (size_t)(t + 2) * kstep; const char* b2 = last ? nB : cB + (size_t)(t + 2) * kstep;
            const char* a3 = a2 + kstep; const char* b3 = b2 + kstep;
            if (last && has_next) S.a_ready(nxt);
            if constexpr (SP2) {
            PG8_LDB(B0, 0, 0); PG8_LDB(B1, 0, 1); PG8_SCHED; PG8_LDA(At, 0, 0); PG8_STAGE(PG8_SA(1, 1), a1 + hstep, voffA);
            PG8_WAIT_V(8); PG8_WAIT_L(0); PG8_BAR; PG8_MMA(0, 0, At, B0); PG8_MMA(0, 1, At, B1); PG8_BAR; PG8_SCHED;
            PG8_LDA(At, 0, 1); PG8_STAGE(PG8_SB(0, 0), b2, voffB); PG8_STAGE(PG8_SB(0, 1), b2 + hstep, voffB); PG8_STAGE(PG8_SA(0, 0), a2, voffA);
            PG8_WAIT_V(8); PG8_WAIT_L(0); PG8_BAR; PG8_MMA(1, 0, At, B0); PG8_MMA(1, 1, At, B1); PG8_BAR; PG8_SCHED;
            PG8_LDB(B0, 1, 0); PG8_LDB(B1, 1, 1); PG8_SCHED; PG8_LDA(At, 1, 0); PG8_STAGE(PG8_SA(0, 1), a2 + hstep, voffA);
            PG8_WAIT_V(8); PG8_WAIT_L(0); PG8_BAR; PG8_MMA(0, 0, At, B0); PG8_MMA(0, 1, At, B1); PG8_BAR; PG8_SCHED;
            PG8_LDA(At, 1, 1); PG8_STAGE(PG8_SB(1, 0), b3, voffB); PG8_STAGE(PG8_SB(1, 1), b3 + hstep, voffB); PG8_STAGE(PG8_SA(1, 0), a3, voffA);
            PG8_WAIT_V(8); PG8_WAIT_L(0); PG8_BAR; PG8_MMA(1, 0, At, B0); PG8_MMA(1, 1, At, B1); PG8_BAR; PG8_SCHED;
            } else {
            PG8_LDB(B0, 0, 0); PG8_SCHED; PG8_LDA(At, 0, 0); PG8_STAGE(PG8_SA(1, 1), a1 + hstep, voffA);
            PG8_WAIT_L(8); PG8_BAR; PG8_WAIT_L(0); PG8_MMA(0, 0, At, B0); PG8_BAR; PG8_SCHED;
            PG8_LDB(B1, 0, 1); PG8_STAGE(PG8_SB(0, 0), b2, voffB);
            PG8_BAR; PG8_WAIT_L(0); PG8_MMA(0, 1, At, B1); PG8_BAR;
            PG8_LDA(At, 0, 1); PG8_STAGE(PG8_SA(0, 0), a2, voffA);
            PG8_BAR; PG8_WAIT_L(0); PG8_MMA(1, 0, At, B0); PG8_BAR; PG8_SCHED;
            PG8_STAGE(PG8_SB(0, 1), b2 + hstep, voffB);
            PG8_WAIT_V(6); PG8_BAR; PG8_MMA(1, 1, At, B1); PG8_BAR;
            PG8_LDB(B0, 1, 0); PG8_SCHED; PG8_LDA(At, 1, 0); PG8_STAGE(PG8_SA(0, 1), a2 + hstep, voffA);
            PG8_WAIT_L(8); PG8_BAR; PG8_WAIT_L(0); PG8_MMA(0, 0, At, B0); PG8_BAR; PG8_SCHED;
            PG8_LDB(B1, 1, 1); PG8_STAGE(PG8_SB(1, 0), b3, voffB);
            PG8_BAR; PG8_WAIT_L(0); PG8_MMA(0, 1, At, B1); PG8_BAR;
            PG8_LDA(At, 1, 1); PG8_STAGE(PG8_SA(1, 0), a3, voffA);
            PG8_BAR; PG8_WAIT_L(0); PG8_MMA(1, 0, At, B0); PG8_BAR; PG8_SCHED;
            PG8_STAGE(PG8_SB(1, 1), b3 + hstep, voffB);
            PG8_WAIT_V(6); PG8_BAR; PG8_MMA(1, 1, At, B1); PG8_BAR;
            }
        }
        if constexpr (ALIGN_EPI) { if (wr == 0) PG8_BAR; }
        if constexpr (!Epi::AFTER_DRAIN) { E(acc, cur, wr, wc, fr, fq); S.done(cur); }
        if (!has_next) break;
#pragma unroll
        for (int a = 0; a < 2; ++a)
#pragma unroll
            for (int b = 0; b < 2; ++b)
#pragma unroll
                for (int m = 0; m < 4; ++m)
#pragma unroll
                    for (int n = 0; n < 2; ++n) acc[a][b][m][n] = (f32x4){0.f, 0.f, 0.f, 0.f};
        cur = nxt; cA = nA; cB = nB; nt = cur.nt; ++ui;
        if constexpr (ALIGN_EPI) { if (wr == 1) PG8_BAR; }
    }
    PG8_WAIT_V(0);
    if constexpr (!ALIGN_EPI) { if (wr == 0) PG8_BAR; }
    PG8_BAR;
    if constexpr (Epi::AFTER_DRAIN) { E.fused(acc, cur, wr, wc, fr, fq, lds, wid, lane); S.done(cur); }
#undef PG8_SA
#undef PG8_SB
#undef PG8_STAGE
#undef PG8_LDA
#undef PG8_LDB
#undef PG8_MMA
#undef PG8_WAIT_V
#undef PG8_WAIT_L
#undef PG8_BAR
#undef PG8_SCHED
}
}

#define GAS __attribute__((address_space(1)))
typedef unsigned v4u __attribute__((ext_vector_type(4)));
typedef unsigned v2u __attribute__((ext_vector_type(2)));
typedef float f32x4 __attribute__((ext_vector_type(4)));
__device__ __forceinline__ unsigned pk2(float lo, float hi) { return (unsigned)f2bf(lo) | ((unsigned)f2bf(hi) << 16); }
__device__ __forceinline__ float wave_sum(float v) {
#pragma unroll
    for (int o = 1; o < 64; o <<= 1) v += __shfl_xor(v, o);
    return v;
}
#define XB_TMO      128
#define XB_XCNT(j)  (256  + 64 * (j))
#define XB_XSUB(j)  (1280 + 64 * (j))
#define XB_XGEN(j)  (2304 + 64 * (j))
#define XB_TOP      3328
#define XB_TOPGEN   3392
#define XCD_BAR_WORDS 3456
#define XB_SPIN_CAP (1u << 25)
#define LAS __attribute__((address_space(3)))

__device__ __forceinline__ unsigned xb_ld(unsigned* p)              { return __hip_atomic_load(p, __ATOMIC_RELAXED, __HIP_MEMORY_SCOPE_AGENT); }
__device__ __forceinline__ unsigned xb_add(unsigned* p, unsigned v) { return __hip_atomic_fetch_add(p, v, __ATOMIC_RELAXED, __HIP_MEMORY_SCOPE_AGENT); }
__device__ __forceinline__ unsigned xb_xcc_id() { return (unsigned)__builtin_amdgcn_s_getreg((3 << 11) | 20) & 0xFu; }
#define XB_SPIN(cond, bar) do { unsigned _sp = 0; while (cond) { __builtin_amdgcn_s_sleep(1); \
    if ((++_sp & 255u) == 0u) { if (xb_ld(&(bar)[XB_TMO])) break; if (_sp > XB_SPIN_CAP) { atomicAdd(&(bar)[XB_TMO], 1u); break; } } } } while (0)

struct XcdBarrier {
    unsigned* bar; unsigned x;
    volatile LAS unsigned* st;
};

__device__ __forceinline__ XcdBarrier xcd_barrier_post(unsigned* bar, volatile LAS unsigned* st) {
    XcdBarrier b; b.bar = bar; b.x = xb_xcc_id(); b.st = st;
    if (threadIdx.x == 0) (void)xb_add(&bar[XB_XCNT(b.x)], 1u);
    return b;
}
__device__ __forceinline__ void xcd_barrier_complete(unsigned* bar, unsigned x, unsigned& nloc, unsigned& nx) {
    const unsigned G = gridDim.x * gridDim.y * gridDim.z;
    unsigned sum, cnt, mine, sp = 0u;
    for (;;) {
        sum = 0u; cnt = 0u; mine = 0u;
#pragma unroll
        for (unsigned j = 0; j < 16; ++j) { const unsigned c = xb_ld(&bar[XB_XCNT(j)]); sum += c; cnt += (c > 0u) ? 1u : 0u; mine = (j == x) ? c : mine; }
        if (sum == G) break;
        __builtin_amdgcn_s_sleep(1);
        if ((++sp & 255u) == 0u) { if (xb_ld(&bar[XB_TMO])) break; if (sp > XB_SPIN_CAP) { atomicAdd(&bar[XB_TMO], 1u); break; } }
    }
    nloc = mine > 0u ? mine : 1u; nx = cnt > 0u ? cnt : 1u;
}

__device__ __forceinline__ void xcd_barrier(const XcdBarrier& b) {
    asm volatile("s_waitcnt vmcnt(0)" ::: "memory");
    __syncthreads();
    if (threadIdx.x == 0) {
        unsigned* bar = b.bar;
        __builtin_amdgcn_s_waitcnt(0);
        unsigned nloc = b.st[0], nx = b.st[1];
        if (nloc == 0u) { xcd_barrier_complete(bar, b.x, nloc, nx); b.st[0] = nloc; b.st[1] = nx; }
        const unsigned old = xb_add(&bar[XB_XSUB(b.x)], 1u);
        const unsigned gen = old / nloc;
        if (old + 1u == (gen + 1u) * nloc) {
            __builtin_amdgcn_fence(__ATOMIC_RELEASE, "agent");
            asm volatile("s_waitcnt vmcnt(0)" ::: "memory");
            const unsigned og = xb_add(&bar[XB_TOP], 1u);
            const unsigned tg = og / nx;
            if (og + 1u == (tg + 1u) * nx) xb_add(&bar[XB_TOPGEN], 1u);
            else XB_SPIN(xb_ld(&bar[XB_TOPGEN]) == tg, bar);
            __builtin_amdgcn_fence(__ATOMIC_ACQUIRE, "agent");
            xb_add(&bar[XB_XGEN(b.x)], 1u);
            asm volatile("s_waitcnt vmcnt(0)" ::: "memory");
        } else {
            XB_SPIN(xb_ld(&bar[XB_XGEN(b.x)]) == gen, bar);
            __builtin_amdgcn_fence(__ATOMIC_ACQUIRE, "agent");
            asm volatile("s_waitcnt vmcnt(0)" ::: "memory");
        }
    }
    __syncthreads();
}

#ifndef DUPMASK
#define DUPMASK 0
#endif
#define DUP(bit) for (int rep_ = 0; rep_ < ((DUPMASK & (bit)) ? 2 : 1); ++rep_)
constexpr int NWAVES = 8, NTHR = 512;
constexpr int LDS_STAGE = 131072;
constexpr int LDS_CTL = 147456 - 256;
constexpr int LDS_BYTES = 147456;
constexpr int CW_BAR = 4096;

__device__ __forceinline__ int fresh_tid() { int t = (int)threadIdx.x; asm volatile("" : "+v"(t)); return t; }
__device__ __forceinline__ int fresh_bid() { int b = (int)blockIdx.x; asm volatile("" : "+s"(b)); return b; }
__device__ __forceinline__ int fresh_vbid(int G) { const int b = fresh_bid(); return (G & 7) == 0 ? (b & 7) * (G >> 3) + (b >> 3) : b; }
struct Frame { LAS unsigned char* lds; int G; };
#define NAIVE_IDS() const long gid_ = (long)fresh_bid() * NTHR + fresh_tid(), nth_ = (long)F.G * NTHR
constexpr Dims mk_df() { Dims d = make_dims(2048, 8, 2048, 256, 4); d.rope_perm = 1; return d; }
constexpr Dims DF = mk_df();
constexpr size_t MiB = 1u << 20;
constexpr size_t rup(size_t b) { return (b + MiB - 1) / MiB * MiB; }
constexpr int H1F = DF.HS * 128, KTF = DF.S + DF.CTX;
constexpr int GDN_REC_BYTES = 74752;
constexpr size_t REC_TOTAL = (size_t)DF.B * DF.HS * 36 * 2 * GDN_REC_BYTES;
constexpr size_t WS_CTL = 0, WS_MODV = WS_CTL + MiB, WS_WTIN = WS_MODV + rup((size_t)DF.DEPTH * (DF.B + 1) * 6 * DF.D * 4), WS_WTOUT = WS_WTIN + rup((size_t)DF.NPE * DF.D * 2),
    WS_WTGU = WS_WTOUT + rup((size_t)DF.D * DF.D * 2), WS_WTDN = WS_WTGU + rup((size_t)2 * DF.FF * DF.D * 2), WS_H = WS_WTDN + rup((size_t)DF.D * DF.FF * 2),
    WS_PROJ = WS_H + rup((size_t)DF.M * DF.D * 4), WS_AB = WS_PROJ + rup((size_t)DF.M * DF.NPE * 2),
    WS_REC = WS_AB + rup((size_t)DF.M * DF.ABW * 4), WS_U = WS_REC,
    WS_DQB = WS_REC + rup(REC_TOTAL), WS_DKB = WS_DQB + rup((size_t)DF.M * H1F * 2), WS_DVT = WS_DKB + rup((size_t)DF.M * H1F * 2),
    WS_OGDN = WS_DVT + rup((size_t)DF.B * H1F * KTF * 2), WS_ODIFF = WS_OGDN + rup((size_t)2 * DF.M * H1F * 4), WS_END = WS_ODIFF + rup((size_t)2 * DF.M * H1F * 4);
static_assert(REC_TOTAL >= (size_t)DF.M * DF.D * 2 + (size_t)DF.B * 256 * KTF * 2, "u and the window V^T fit inside the record arena");
struct KArgs { const float* in[26]; float* out; unsigned char* ws; };
__device__ __forceinline__ Params mk_params(const KArgs& a) {
    unsigned char* ws = a.ws; asm volatile("" : "+s"(ws));
    Params P;
    P.x = a.in[0]; P.c = a.in[1]; P.ctx = a.in[2]; P.c_ctx = a.in[3]; P.ada_w = a.in[4]; P.ada_b = a.in[5]; P.norm_mix_g = a.in[6]; P.norm_ffn_g = a.in[7];
    P.w_in_even = a.in[8]; P.gdn_conv_w = a.in[9]; P.gdn_a_log = a.in[10]; P.gdn_dt_bias = a.in[11]; P.gdn_norm_g = a.in[12]; P.lq1 = a.in[13]; P.lk1 = a.in[14]; P.lq2 = a.in[15]; P.lk2 = a.in[16];
    P.subln_g = a.in[17]; P.w_in_odd = a.in[18]; P.na_rpb = a.in[19]; P.win_sink = a.in[20]; P.w_out = a.in[21]; P.ffn_wg = a.in[22]; P.ffn_wu = a.in[23]; P.ffn_wd = a.in[24]; P.final_g = a.in[25];
    P.out = a.out;
    P.rope32 = (float*)(ws + WS_CTL + 512 * 1024); P.rope64 = P.rope32 + 64 * 16 * 2;
    P.ctl = (unsigned*)(ws + WS_CTL); P.modv = (float*)(ws + WS_MODV); P.wt_in = (act_t*)(ws + WS_WTIN); P.wt_out = (act_t*)(ws + WS_WTOUT); P.wt_gu = (act_t*)(ws + WS_WTGU); P.wt_dn = (act_t*)(ws + WS_WTDN);
    P.h = (float*)(ws + WS_H); P.hb = (act_t*)(ws + WS_H); P.u = (act_t*)(ws + WS_U); P.y = P.u; P.proj = (act_t*)(ws + WS_PROJ); P.hid = P.proj; P.ab = (float*)(ws + WS_AB);
    P.qkvact = nullptr; P.gbuf = nullptr; P.betabuf = nullptr;
    P.dq_b = (act_t*)(ws + WS_DQB); P.dk_b = (act_t*)(ws + WS_DKB); P.dvT = (act_t*)(ws + WS_DVT); P.ogdn = (float*)(ws + WS_OGDN); P.odiff = (float*)(ws + WS_ODIFF);
    P.wq_b = P.dq_b; P.wk_b = P.dk_b; P.nvT = P.dvT; P.wvT = (act_t*)(ws + WS_REC + rup((size_t)DF.M * DF.D * 2));
    return P;
}

namespace att {
typedef short bf16x8 __attribute__((ext_vector_type(8)));
typedef short s16x4 __attribute__((ext_vector_type(4)));
typedef float f32x16 __attribute__((ext_vector_type(16)));
typedef float f32x4 __attribute__((ext_vector_type(4)));
typedef unsigned u32x4 __attribute__((ext_vector_type(4)));
typedef unsigned u32x2 __attribute__((ext_vector_type(2)));
typedef __bf16 bf2_t __attribute__((ext_vector_type(2)));
typedef float f2_t __attribute__((ext_vector_type(2)));
#define ATT_DI __device__ __forceinline__
ATT_DI unsigned pkbf(float a, float b) { f2_t v = {a, b}; bf2_t r = __builtin_convertvector(v, bf2_t); return __builtin_bit_cast(unsigned, r); }
constexpr float L2E = 1.4426950408889634f, NEG = -1.0e30f;
constexpr int VRS = 320, VBUF = 64 * VRS;
template <int DQK> struct Geo {
    static constexpr int KRS = DQK * 2 + 16, KBUF = 64 * KRS;
    static constexpr int KCH = DQK / 8, KPT = 64 * KCH / 512;
    static constexpr int TOTAL = 2 * KBUF + 3 * VBUF;
};
ATT_DI int simd_rank(LAS unsigned char* w4, int tid) {
    volatile LAS unsigned* c = (volatile LAS unsigned*)w4;
    asm volatile("s_waitcnt lgkmcnt(0)" ::: "memory"); __builtin_amdgcn_s_barrier(); asm volatile("" ::: "memory");
    if (tid < 4) c[tid] = 0u;
    asm volatile("s_waitcnt lgkmcnt(0)" ::: "memory"); __builtin_amdgcn_s_barrier(); asm volatile("" ::: "memory");
    const unsigned simd = __builtin_amdgcn_s_getreg((1 << 11) | (4 << 6) | 4) & 3u;
    unsigned rk = 0u; if ((tid & 63) == 0) rk = __hip_atomic_fetch_add((LAS unsigned*)w4 + simd, 1u, __ATOMIC_RELAXED, __HIP_MEMORY_SCOPE_WORKGROUP);
    rk = __builtin_amdgcn_readfirstlane(rk);
    asm volatile("s_waitcnt lgkmcnt(0)" ::: "memory"); __builtin_amdgcn_s_barrier(); asm volatile("" ::: "memory");
    return (int)(rk & 1u);
}
struct TileSrc { const bf16_t* k; int kstride; const bf16_t* v; int vstride; };

template <int DQK, class U> ATT_DI void run_unit(LAS unsigned char* lds, const U& u, int tid, int grp) {
    typedef Geo<DQK> G;
    const int lane = tid & 63, wave = __builtin_amdgcn_readfirstlane(tid >> 6), ql = lane & 31, h = lane >> 5;
    bf16x8 qf[DQK / 16];
    { const bf16_t* qp = u.qrow(wave, ql);
#pragma unroll
      for (int s = 0; s < DQK / 16; ++s) qf[s] = *(const bf16x8*)(qp + 16 * s + 8 * h); }
    f32x16 O[4];
#pragma unroll
    for (int t = 0; t < 4; ++t)
#pragma unroll
        for (int r = 0; r < 16; ++r) O[t][r] = 0.f;
    float m = u.m_init(wave, ql), l = h == 0 ? u.l_init(wave, ql) : 0.f;
    u32x4 kr[G::KPT], vr[2];
    const int nt = u.ntiles();
    auto gload = [&](int i) {
        const TileSrc t = u.tile(i);
#pragma unroll
        for (int c = 0; c < G::KPT; ++c) { const int cid = tid + 512 * c, row = cid / G::KCH, cc = cid % G::KCH; kr[c] = *(const u32x4*)(t.k + (size_t)row * t.kstride + cc * 8); }
#pragma unroll
        for (int c = 0; c < 2; ++c) { const int cid = tid + 512 * c, row = cid >> 4, cc = cid & 15; vr[c] = *(const u32x4*)(t.v + (size_t)row * t.vstride + cc * 8); }
    };
    auto lstore = [&](int b, int vslot) {
        LAS unsigned char* kb = lds + b * G::KBUF; LAS unsigned char* vb = lds + 2 * G::KBUF + vslot;
#pragma unroll
        for (int c = 0; c < G::KPT; ++c) { const int cid = tid + 512 * c, row = cid / G::KCH, cc = cid % G::KCH; *(LAS u32x4*)(kb + row * G::KRS + cc * 16) = kr[c]; }
#pragma unroll
        for (int c = 0; c < 2; ++c) { const int cid = tid + 512 * c, row = cid >> 4, cc = cid & 15; *(LAS u32x4*)(vb + row * VRS + cc * 16) = vr[c]; }
    };
    asm volatile("s_waitcnt lgkmcnt(0)" ::: "memory"); __builtin_amdgcn_s_barrier(); asm volatile("" ::: "memory");
    constexpr bool LATE = DQK == 64;
    bf16x8 pf[2][2];
    auto pv = [&](const LAS unsigned char* vb) {
        constexpr int PG = DQK == 64 ? 4 : 2;
        const int l16 = lane & 15;
        const LAS unsigned char* vp0 = vb + ((l16 >> 2) + 4 * h) * VRS + (16 * ((lane >> 4) & 1) + 4 * (l16 & 3)) * 2;
        s16x4 lo[PG], hi[PG], nlo[PG], nhi[PG];
#pragma unroll
        for (int k = 0; k < PG; ++k) { const int st = k, t = st >> 2, kt = (st >> 1) & 1, s2 = st & 1; const LAS unsigned char* vp = vp0 + (32 * kt + 16 * s2) * VRS + 64 * t;
            lo[k] = __builtin_amdgcn_ds_read_tr16_b64_v4i16((LAS s16x4*)vp); hi[k] = __builtin_amdgcn_ds_read_tr16_b64_v4i16((LAS s16x4*)(vp + 8 * VRS)); }
#pragma unroll
        for (int g = 0; g < 16 / PG; ++g) {
#pragma unroll
            for (int k = 0; k < PG; ++k) { nlo[k] = lo[k]; nhi[k] = hi[k]; }
            if (g + 1 < 16 / PG) {
#pragma unroll
                for (int k = 0; k < PG; ++k) { const int st = (g + 1) * PG + k, t = st >> 2, kt = (st >> 1) & 1, s2 = st & 1; const LAS unsigned char* vp = vp0 + (32 * kt + 16 * s2) * VRS + 64 * t;
                    nlo[k] = __builtin_amdgcn_ds_read_tr16_b64_v4i16((LAS s16x4*)vp); nhi[k] = __builtin_amdgcn_ds_read_tr16_b64_v4i16((LAS s16x4*)(vp + 8 * VRS)); } }
            __builtin_amdgcn_s_setprio(1);
#pragma unroll
            for (int k = 0; k < PG; ++k) { const int st = g * PG + k, t = st >> 2, kt = (st >> 1) & 1, s2 = st & 1;
                const bf16x8 av = {lo[k][0], lo[k][1], lo[k][2], lo[k][3], hi[k][0], hi[k][1], hi[k][2], hi[k][3]};
                O[t] = __builtin_amdgcn_mfma_f32_32x32x16_bf16(av, pf[kt][s2], O[t], 0, 0, 0); }
            __builtin_amdgcn_s_setprio(0);
#pragma unroll
            for (int k = 0; k < PG; ++k) { lo[k] = nlo[k]; hi[k] = nhi[k]; }
            __builtin_amdgcn_sched_barrier(0);
        }
    };
    auto qk_sm = [&](int i, const LAS unsigned char* kb) {
        f32x16 s0, s1;
#pragma unroll
        for (int r = 0; r < 16; ++r) { s0[r] = 0.f; s1[r] = 0.f; }
        {
            const LAS unsigned char* k0p = kb + ql * G::KRS + 16 * h; const LAS unsigned char* k1p = k0p + 32 * G::KRS;
            bf16x8 a0[2], a1[2], n0[2], n1[2];
#pragma unroll
            for (int k = 0; k < 2; ++k) { a0[k] = *(const LAS bf16x8*)(k0p + 32 * k); a1[k] = *(const LAS bf16x8*)(k1p + 32 * k); }
#pragma unroll
            for (int g = 0; g < DQK / 32; ++g) {
#pragma unroll
                for (int k = 0; k < 2; ++k) { n0[k] = a0[k]; n1[k] = a1[k]; }
                if (g + 1 < DQK / 32) {
#pragma unroll
                    for (int k = 0; k < 2; ++k) { n0[k] = *(const LAS bf16x8*)(k0p + 32 * (2 * g + 2 + k)); n1[k] = *(const LAS bf16x8*)(k1p + 32 * (2 * g + 2 + k)); } }
#pragma unroll
                for (int k = 0; k < 2; ++k) { s0 = __builtin_amdgcn_mfma_f32_32x32x16_bf16(a0[k], qf[2 * g + k], s0, 0, 0, 0); s1 = __builtin_amdgcn_mfma_f32_32x32x16_bf16(a1[k], qf[2 * g + k], s1, 0, 0, 0); }
#pragma unroll
                for (int k = 0; k < 2; ++k) { a0[k] = n0[k]; a1[k] = n1[k]; }
                __builtin_amdgcn_sched_barrier(0);
            }
        }
        u.scores(i, wave, ql, h, s0, s1);
        float mx = NEG;
#pragma unroll
        for (int r = 0; r < 16; ++r) mx = fmaxf(mx, fmaxf(s0[r], s1[r]));
        { const unsigned mu = __builtin_bit_cast(unsigned, mx); const auto sw = __builtin_amdgcn_permlane32_swap(mu, mu, false, false);
          mx = fmaxf(mx, __builtin_bit_cast(float, h ? sw[0] : sw[1])); }
        const float mn = mx > m + 8.0f ? mx : m, alpha = __builtin_amdgcn_exp2f(m - mn); m = mn;
        float ps = 0.f;
#pragma unroll
        for (int r = 0; r < 16; ++r) { s0[r] = __builtin_amdgcn_exp2f(s0[r] - mn); s1[r] = __builtin_amdgcn_exp2f(s1[r] - mn); ps += s0[r] + s1[r]; }
        l = l * alpha + ps;
        if (__any(alpha != 1.0f)) {
#pragma unroll
            for (int t = 0; t < 4; ++t)
#pragma unroll
                for (int r = 0; r < 16; ++r) O[t][r] *= alpha; }
#pragma unroll
        for (int s2 = 0; s2 < 2; ++s2) {
            u32x4 p0, p1;
            p0.x = pkbf(s0[8 * s2 + 0], s0[8 * s2 + 1]); p0.y = pkbf(s0[8 * s2 + 2], s0[8 * s2 + 3]); p0.z = pkbf(s0[8 * s2 + 4], s0[8 * s2 + 5]); p0.w = pkbf(s0[8 * s2 + 6], s0[8 * s2 + 7]);
            p1.x = pkbf(s1[8 * s2 + 0], s1[8 * s2 + 1]); p1.y = pkbf(s1[8 * s2 + 2], s1[8 * s2 + 3]); p1.z = pkbf(s1[8 * s2 + 4], s1[8 * s2 + 5]); p1.w = pkbf(s1[8 * s2 + 6], s1[8 * s2 + 7]);
            pf[0][s2] = __builtin_bit_cast(bf16x8, p0); pf[1][s2] = __builtin_bit_cast(bf16x8, p1);
        }
    };
    int vprev = 2 * VBUF, vcur = 0, vnext = VBUF; bool have = false;
    gload(0); if (LATE) { lstore(0, vcur); if (nt > 1) gload(1); }
    for (int i = 0; i < nt; ++i) {
        if (!LATE) lstore(i & 1, vcur);
        asm volatile("s_waitcnt lgkmcnt(0)" ::: "memory"); __builtin_amdgcn_s_barrier(); asm volatile("" ::: "memory");
        if (LATE) { if (i + 1 < nt) { lstore((i + 1) & 1, vnext); if (i + 2 < nt) gload(i + 2); } }
        else if (i + 1 < nt) gload(i + 1);
        const LAS unsigned char* vbase = lds + 2 * G::KBUF;
        if (grp && have) pv(vbase + vprev);
        have = u.uses(i, wave);
        if (have) { qk_sm(i, lds + (i & 1) * G::KBUF); if (!grp) pv(vbase + vcur); }
        { const int t = vprev; vprev = vcur; vcur = vnext; vnext = t; }
    }
    if (grp && have) pv(lds + 2 * G::KBUF + vprev);
    const float lt = l + __shfl_xor(l, 32);
    u.store(wave, ql, h, O, 1.0f / lt);
}

struct DiffU {
    const bf16_t *q, *k, *v; float* o;
    int b, head, c, qrow0, lat;
    bf16_t* y; const float* subg; float lam, outscale;
    ATT_DI int ntiles() const { return lat ? 36 : 4; }
    ATT_DI TileSrc tile(int i) const { const int ii = lat ? i : 32 + i; TileSrc t;
        const int krow = ii < 32 ? b * 2048 + 64 * ii : 16384 + b * 256 + 64 * (ii - 32);
        t.k = k + (size_t)krow * 7424 + head * 128 + c * 64; t.kstride = 7424;
        t.v = v + (size_t)krow * 7424 + head * 128; t.vstride = 7424; return t; }
    ATT_DI bool uses(int, int) const { return true; }
    ATT_DI const bf16_t* qrow(int wave, int ql) const { return q + (size_t)(qrow0 + 32 * wave + ql) * 7424 + head * 128 + c * 64; }
    ATT_DI float m_init(int, int) const { return NEG; }
    ATT_DI float l_init(int, int) const { return 0.f; }
    ATT_DI void scores(int, int, int, int, f32x16& s0, f32x16& s1) const {
#pragma unroll
        for (int r = 0; r < 16; ++r) { s0[r] *= 0.125f * L2E; s1[r] *= 0.125f * L2E; } }
    ATT_DI void store(int wave, int ql, int h, const f32x16 (&O)[4], float linv) const {
        const int row = qrow0 + 32 * wave + ql;
        float* op = o + (size_t)row * 1024 + head * 128 + 4 * h;
        if (c == 0) {
#pragma unroll
            for (int t = 0; t < 4; ++t)
#pragma unroll
                for (int g = 0; g < 4; ++g) { f32x4 v = {O[t][4 * g] * linv, O[t][4 * g + 1] * linv, O[t][4 * g + 2] * linv, O[t][4 * g + 3] * linv}; *(f32x4*)(op + 32 * t + 8 * g) = v; }
        } else {
            f32x4 d[4][4]; float ss = 0.f; const float ls = lam * linv;
#pragma unroll
            for (int t = 0; t < 4; ++t)
#pragma unroll
                for (int g = 0; g < 4; ++g) { const f32x4 o0 = *(const f32x4*)(op + 32 * t + 8 * g);
                    d[t][g] = (f32x4){o0[0] - ls * O[t][4 * g], o0[1] - ls * O[t][4 * g + 1], o0[2] - ls * O[t][4 * g + 2], o0[3] - ls * O[t][4 * g + 3]};
                    ss += (d[t][g][0] * d[t][g][0] + d[t][g][1] * d[t][g][1]) + (d[t][g][2] * d[t][g][2] + d[t][g][3] * d[t][g][3]); }
            ss += __shfl_xor(ss, 32);
            const float rn = outscale / sqrtf(ss * (1.0f / 128.f) + 1e-6f);
            bf16_t* yp = y + (size_t)row * 2048 + 1024 + head * 128 + 4 * h;
#pragma unroll
            for (int t = 0; t < 4; ++t)
#pragma unroll
                for (int g = 0; g < 4; ++g) { const f32x4 gg = *(const f32x4*)(subg + 32 * t + 8 * g + 4 * h);
                    *(u32x2*)(yp + 32 * t + 8 * g) = (u32x2){pkbf(d[t][g][0] * rn * gg[0], d[t][g][1] * rn * gg[1]), pkbf(d[t][g][2] * rn * gg[2], d[t][g][3] * rn * gg[3])}; }
        }
    }
};
struct NaU {
    const bf16_t *proj; bf16_t* y; const LAS float* rpb;
    int b, head, R, lat, lo, nloc;
    ATT_DI int ntiles() const { return lat ? nloc + 4 : 4; }
    ATT_DI TileSrc tile(int i) const { TileSrc t; const bool loc = lat && i < nloc; const int j = lat ? i - nloc : i;
        const int krow = loc ? b * 2048 + (lo + i) * 64 : 16384 + b * 256 + 64 * j;
        t.k = proj + (size_t)krow * 4608 + 1024 + head * 128; t.kstride = 4608; t.v = proj + (size_t)krow * 4608 + 2048 + head * 128; t.vstride = 4608; return t; }
    ATT_DI bool uses(int i, int wave) const { if (!lat || i >= nloc) return true; const int gr = lo + i, r = 4 * R + (wave >> 1), r0 = r - 4 < 0 ? 0 : (r - 4 > 24 ? 24 : r - 4); return gr >= r0 && gr <= r0 + 7; }
    ATT_DI int row_of(int wave, int ql) const { return (lat ? b * 2048 + 256 * R : 16384 + b * 256) + 32 * wave + ql; }
    ATT_DI const bf16_t* qrow(int wave, int ql) const { return proj + (size_t)row_of(wave, ql) * 4608 + head * 128; }
    ATT_DI float m_init(int, int) const { return NEG; }
    ATT_DI float l_init(int, int) const { return 0.f; }
    ATT_DI void scores(int i, int wave, int ql, int h, f32x16& s0, f32x16& s1) const {
        const float sc = 0.08838834764831845f * L2E;
        if (!lat || i >= nloc) {
#pragma unroll
            for (int r = 0; r < 16; ++r) { s0[r] *= sc; s1[r] *= sc; }
        } else {
            const int gr = lo + i, rq = 4 * R + (wave >> 1), c = 32 * (wave & 1) + ql, c0 = c - 8 < 0 ? 0 : (c - 8 > 48 ? 48 : c - 8);
            const LAS float* bp = rpb + (gr - rq + 7) * 31 - c + 15;
#pragma unroll
            for (int r = 0; r < 16; ++r) { const int kc = (r & 3) + 8 * (r >> 2) + 4 * h;
                s0[r] = (kc >= c0 && kc < c0 + 16) ? s0[r] * sc + bp[kc] : NEG;
                s1[r] = (kc + 32 >= c0 && kc + 32 < c0 + 16) ? s1[r] * sc + bp[kc + 32] : NEG; }
        }
    }
    ATT_DI void store(int wave, int ql, int h, const f32x16 (&O)[4], float linv) const {
        bf16_t* op = y + (size_t)row_of(wave, ql) * 2048 + head * 128 + 4 * h;
#pragma unroll
        for (int t = 0; t < 4; ++t)
#pragma unroll
            for (int g = 0; g < 4; ++g) { u32x2 v = {pkbf(O[t][4 * g] * linv, O[t][4 * g + 1] * linv), pkbf(O[t][4 * g + 2] * linv, O[t][4 * g + 3] * linv)}; *(u32x2*)(op + 32 * t + 8 * g) = v; }
    }
};
struct WinU {
    const bf16_t *q, *k, *v; bf16_t* y; const float* sink;
    int b, kvh, qb, lat, lo, nloc;
    ATT_DI int ntiles() const { return lat ? nloc + 4 : 4; }
    ATT_DI TileSrc tile(int i) const { TileSrc t; const bool loc = lat && i < nloc; const int j = lat ? i - nloc : i;
        const int krow = loc ? b * 2048 + (lo + i) * 64 : 16384 + b * 256 + 64 * j;
        t.k = k + (size_t)krow * 4608 + kvh * 128; t.kstride = 4608; t.v = v + (size_t)krow * 4608 + kvh * 128; t.vstride = 4608; return t; }
    ATT_DI bool uses(int, int) const { return true; }
    ATT_DI int row_of(int wave, int ql) const { return (lat ? b * 2048 : 16384 + b * 256) + 64 * qb + 32 * (wave & 1) + ql; }
    ATT_DI int head_of(int wave) const { return 4 * kvh + (wave >> 1); }
    ATT_DI const bf16_t* qrow(int wave, int ql) const { return q + (size_t)row_of(wave, ql) * 4608 + head_of(wave) * 128; }
    ATT_DI float m_init(int wave, int) const { return sink[head_of(wave)] * L2E; }
    ATT_DI float l_init(int, int) const { return 1.0f; }
    ATT_DI void scores(int i, int wave, int ql, int h, f32x16& s0, f32x16& s1) const {
        const float sc = 0.08838834764831845f * L2E;
        if (!lat || i >= nloc) {
#pragma unroll
            for (int r = 0; r < 16; ++r) { s0[r] *= sc; s1[r] *= sc; }
        } else {
            const int dq = 64 * qb + 32 * (wave & 1) + ql - (lo + i) * 64;
#pragma unroll
            for (int r = 0; r < 16; ++r) { const int kc = (r & 3) + 8 * (r >> 2) + 4 * h; const int d0 = dq - kc, d1 = dq - kc - 32;
                s0[r] = (d0 <= 128 && d0 >= -128) ? s0[r] * sc : NEG;
                s1[r] = (d1 <= 128 && d1 >= -128) ? s1[r] * sc : NEG; }
        }
    }
    ATT_DI void store(int wave, int ql, int h, const f32x16 (&O)[4], float linv) const {
        bf16_t* op = y + (size_t)row_of(wave, ql) * 2048 + 1024 + head_of(wave) * 128 + 4 * h;
#pragma unroll
        for (int t = 0; t < 4; ++t)
#pragma unroll
            for (int g = 0; g < 4; ++g) { u32x2 v = {pkbf(O[t][4 * g] * linv, O[t][4 * g + 1] * linv), pkbf(O[t][4 * g + 2] * linv, O[t][4 * g + 3] * linv)}; *(u32x2*)(op + 32 * t + 8 * g) = v; }
    }
};
}

namespace gdn {
using att::bf16x8; using att::s16x4; using att::f32x16; using att::f32x4; using att::u32x4; using att::u32x2; using att::pkbf;
#define GDN_DI __device__ __forceinline__
constexpr int REC_W = 0, REC_Q = 16384, REC_AT = 32768, REC_KT = 40960, REC_UT = 57344, REC_SC = 73728, REC_BYTES = 74752;
static_assert(REC_BYTES == GDN_REC_BYTES, "record size vs workspace map");
constexpr float SCALE = 0.08838834764831845f;
constexpr int L_KT = 0, L_VT = 18432, L_TAB = 36864, L_X = 38912;
constexpr int L_KR = L_X, L_QR = L_X + 17408, L_GM = L_X + 34816, L_QKM = L_GM + 16640;
constexpr int L_AT0 = L_KR, L_AT1 = L_QR;
constexpr int TRS = 192;
constexpr int L_TPT = L_GM, L_ATT = L_TPT + 4 * 64 * TRS, L_END = L_ATT + 2 * 9216;
static_assert(L_QKM + 16640 <= L_ATT && L_END <= 147200, "G1 LDS map");
constexpr int RS128 = 272, RS64 = 144;
GDN_DI int chunk_base(int b, int cix) { return cix < 4 ? 16384 + b * 256 + 64 * cix : b * 2048 + 64 * (cix - 4); }
GDN_DI size_t rec_off(int b, int h, int cix, int dir) { return (size_t)((((b * 8 + h) * 36 + cix) * 2) + dir) * REC_BYTES; }
GDN_DI unsigned rot16(unsigned x) { return (x >> 16) | (x << 16); }
GDN_DI void wg_bar() { asm volatile("s_waitcnt vmcnt(0) lgkmcnt(0)" ::: "memory"); __builtin_amdgcn_s_barrier(); asm volatile("" ::: "memory"); }
GDN_DI void lds_bar() { asm volatile("s_waitcnt lgkmcnt(0)" ::: "memory"); __builtin_amdgcn_s_barrier(); asm volatile("" ::: "memory"); }
GDN_DI bf16x8 tr_frag(const LAS unsigned char* blk, int stride, int lane) {
    const int l16 = lane & 15; const LAS unsigned char* p = blk + (l16 >> 2) * stride + (16 * ((lane >> 4) & 1) + 4 * (l16 & 3)) * 2;
    const s16x4 lo = __builtin_amdgcn_ds_read_tr16_b64_v4i16((LAS s16x4*)p), hi = __builtin_amdgcn_ds_read_tr16_b64_v4i16((LAS s16x4*)(p + 4 * stride));
    return (bf16x8){lo[0], lo[1], lo[2], lo[3], hi[0], hi[1], hi[2], hi[3]};
}

GDN_DI void g1_item(LAS unsigned char* lds, const bf16_t* proj  , const float* ab  , const float* conv_w  , const float* a_log, const float* dt_bias  ,
                    unsigned char* recs, int b, int h, int cix, int tid) {
    const int lane = tid & 63, wave = __builtin_amdgcn_readfirstlane(tid >> 6), r = lane & 31, hh = lane >> 5;
    const int base = chunk_base(b, cix), Tn = cix < 4 ? 256 : 2048, t0 = cix < 4 ? 64 * cix : 64 * (cix - 4);
    LAS float* tabG = (LAS float*)(lds + L_TAB); LAS float* tabB = tabG + 128; LAS float* gct = tabB + 128; LAS float* bt = gct + 128;
#pragma unroll
    for (int m = 0; m < 3; ++m)
#pragma unroll
        for (int c = 0; c < 2; ++c) {
            const int p = tid + 512 * c, i = p >> 4, grp = p & 15, t = t0 + i, col = m * 1024 + h * 128 + 8 * grp;
            const bf16_t* src = proj + (size_t)(base + i) * 7424 + col;
            const bf16x8 x0 = *(const bf16x8*)src; bf16x8 xm = {0, 0, 0, 0, 0, 0, 0, 0}, xp = {0, 0, 0, 0, 0, 0, 0, 0};
            if (t > 0) xm = *(const bf16x8*)(src - 7424);
            if (t < Tn - 1) xp = *(const bf16x8*)(src + 7424);
            const f32x4 w0a = *(const f32x4*)(conv_w + col), w0b = *(const f32x4*)(conv_w + col + 4), w1a = *(const f32x4*)(conv_w + 3072 + col), w1b = *(const f32x4*)(conv_w + 3072 + col + 4),
                        w2a = *(const f32x4*)(conv_w + 6144 + col), w2b = *(const f32x4*)(conv_w + 6144 + col + 4);
            float v[8]; float ss = 0.f;
#pragma unroll
            for (int e = 0; e < 8; ++e) { const float w0 = e < 4 ? w0a[e & 3] : w0b[e & 3], w1 = e < 4 ? w1a[e & 3] : w1b[e & 3], w2 = e < 4 ? w2a[e & 3] : w2b[e & 3];
                const float z = bf2f((bf16_t)xm[e]) * w0 + bf2f((bf16_t)x0[e]) * w1 + bf2f((bf16_t)xp[e]) * w2; v[e] = z / (1.0f + __expf(-z)); ss += v[e] * v[e]; }
            if (m < 2) { ss += __shfl_xor(ss, 1); ss += __shfl_xor(ss, 2); ss += __shfl_xor(ss, 4); ss += __shfl_xor(ss, 8); const float rn = 1.0f / sqrtf(ss + 1e-6f);
#pragma unroll
                for (int e = 0; e < 8; ++e) v[e] *= rn; }
            u32x4 pk; pk.x = pkbf(v[0], v[1]); pk.y = pkbf(v[2], v[3]); pk.z = pkbf(v[4], v[5]); pk.w = pkbf(v[6], v[7]);
            if (m == 0) *(LAS u32x4*)(lds + L_QR + i * RS128 + grp * 16) = pk;
            if (m == 1) *(LAS u32x4*)(lds + L_KR + i * RS128 + grp * 16) = pk;
            if (m >= 1) { LAS unsigned char* tb = lds + (m == 1 ? L_KT : L_VT) + (8 * grp) * RS64 + i * 2;
#pragma unroll
                for (int e = 0; e < 8; ++e) *(LAS bf16_t*)(tb + e * RS64) = f2bf(v[e]); }
        }
    if (tid < 128) { const int dir = tid >> 6, i = tid & 63; const float* abr = ab + (size_t)(base + i) * 32;
        const float a = abr[dir * 8 + h], bb = abr[16 + dir * 8 + h], x = a + dt_bias[dir * 8 + h];
        const float ex = __expf(x); const float sp = x > 20.f ? x : (ex < 1e-3f ? ex * (1.0f - 0.5f * ex) : __logf(1.0f + ex));
        tabG[dir * 64 + i] = -__expf(a_log[dir * 8 + h]) * sp; tabB[dir * 64 + i] = 1.0f / (1.0f + __expf(-bb)); }
    lds_bar();
#pragma unroll
    for (int k = 0; k < 2; ++k) { const int f = wave * 2 + k, rt = (f >> 3) & 1, ks = f & 7; const int tok = 32 * rt + r;
        const LAS unsigned char* p = lds + L_QR + tok * RS128 + (16 * ks + 4 * hh) * 2; const u32x2 lo = *(const LAS u32x2*)p, hi = *(const LAS u32x2*)(p + 16);
        *(u32x4*)(recs + rec_off(b, h, cix, 0) + REC_Q + (rt * 8 + ks) * 1024 + lane * 16) = (u32x4){lo.x, lo.y, hi.x, hi.y}; }
    { const int mat = wave >> 2, ti = (wave >> 1) & 1, tj = wave & 1;
      const LAS unsigned char* ap = lds + (mat ? L_QR : L_KR) + (32 * ti + r) * RS128 + 16 * hh; const LAS unsigned char* bp = lds + L_KR + (32 * tj + r) * RS128 + 16 * hh;
      f32x16 c; for (int q = 0; q < 16; ++q) c[q] = 0.f;
#pragma unroll
      for (int ks = 0; ks < 8; ++ks) c = __builtin_amdgcn_mfma_f32_32x32x16_bf16(*(const LAS bf16x8*)(ap + 32 * ks), *(const LAS bf16x8*)(bp + 32 * ks), c, 0, 0, 0);
      LAS float* dst = (LAS float*)(lds + (mat ? L_QKM : L_GM));
#pragma unroll
      for (int q = 0; q < 16; ++q) dst[(32 * ti + (q & 3) + 8 * (q >> 2) + 4 * hh) * 65 + 32 * tj + r] = c[q]; }
    if (wave < 2) { const int dir = wave, tok = dir ? 63 - lane : lane; float g = tabG[dir * 64 + tok];
#pragma unroll
        for (int o = 1; o < 64; o <<= 1) { const float y = __shfl_up(g, o); if (lane >= o) g += y; }
        gct[dir * 64 + lane] = g; bt[dir * 64 + lane] = tabB[dir * 64 + tok];
        const float gl = __shfl(g, 63);
        float* sc = (float*)(recs + rec_off(b, h, cix, dir) + REC_SC); sc[lane] = __expf(g) * SCALE; sc[64 + lane] = __expf(gl - g); if (lane == 0) sc[128] = __expf(gl); }
    lds_bar();
#pragma unroll
    for (int c = 0; c < 16; ++c) { const int idx = tid + 512 * c, dir = idx >> 12, ri = (idx >> 6) & 63, rj = idx & 63, i = dir ? 63 - ri : ri, j = dir ? 63 - rj : rj;
        const float dec = rj <= ri ? __expf(gct[dir * 64 + ri] - gct[dir * 64 + rj]) : 0.f;
        ((LAS float*)(lds + (dir ? L_AT1 : L_AT0)))[ri * 68 + rj] = rj < ri ? bt[dir * 64 + ri] * ((const LAS float*)(lds + L_GM))[i * 65 + j] * dec : 0.f;
        *(LAS bf16_t*)(lds + L_ATT + dir * 9216 + ri * RS64 + rj * 2) = f2bf(SCALE * ((const LAS float*)(lds + L_QKM))[i * 65 + j] * dec); }
    lds_bar();
    if ((wave & 3) == 0) { const int dir = wave >> 2; int ln = lane; asm volatile("" : "+v"(ln));
        typedef float f2v __attribute__((ext_vector_type(2)));
        const int blk = ln >> 5, c = ln & 31;
        const LAS float* Ad = (const LAS float*)(lds + (dir ? L_AT1 : L_AT0)); const LAS float* At = Ad + (32 * blk) * 68 + 32 * blk;
        f2v x2[16]; int off = 0;
#pragma unroll
        for (int i = 0; i < 32; ++i) { f2v acc2 = {(i == c) ? 1.0f : 0.0f, 0.0f};
#pragma unroll
            for (int j4 = 0; j4 < (i + 3) / 4; ++j4) { const f32x4 a4 = *(const LAS f32x4*)(At + off + i * 68 + 4 * j4);
                const f2v alo = {a4[0], a4[1]}, ahi = {a4[2], a4[3]};
                f2v xlo = x2[2 * j4], xhi = x2[2 * j4 + 1];
                if (4 * j4 + 0 >= i) xlo.x = 0.f; if (4 * j4 + 1 >= i) xlo.y = 0.f; if (4 * j4 + 2 >= i) xhi.x = 0.f; if (4 * j4 + 3 >= i) xhi.y = 0.f;
                acc2 -= alo * xlo; acc2 -= ahi * xhi; }
            const float acc = acc2.x + acc2.y;
            if (i & 1) x2[i >> 1].y = acc; else x2[i >> 1].x = acc;
            asm volatile("" : "+v"(off) : "v"(acc)); }
        float x[32];
#pragma unroll
        for (int i = 0; i < 32; ++i) x[i] = (i & 1) ? x2[i >> 1].y : x2[i >> 1].x;
        LAS unsigned char* img = lds + L_TPT + (2 * dir) * 64 * TRS;
        { const float b2 = bt[dir * 64 + ln], b1 = b2 * __expf(gct[dir * 64 + ln]); const int tokc = dir ? 63 - ln : ln;
          LAS unsigned char* tp = img + tokc * TRS; LAS unsigned char* tpp = tp + 64 * TRS;
#pragma unroll
          for (int q = 0; q < 4; ++q) {
              *(LAS u32x4*)(tp + 64 * blk + 16 * q) = (u32x4){pkbf(x[8 * q] * b1, x[8 * q + 1] * b1), pkbf(x[8 * q + 2] * b1, x[8 * q + 3] * b1), pkbf(x[8 * q + 4] * b1, x[8 * q + 5] * b1), pkbf(x[8 * q + 6] * b1, x[8 * q + 7] * b1)};
              *(LAS u32x4*)(tpp + 64 * blk + 16 * q) = (u32x4){pkbf(x[8 * q] * b2, x[8 * q + 1] * b2), pkbf(x[8 * q + 2] * b2, x[8 * q + 3] * b2), pkbf(x[8 * q + 4] * b2, x[8 * q + 5] * b2), pkbf(x[8 * q + 6] * b2, x[8 * q + 7] * b2)};
              *(LAS u32x4*)(img + ln * TRS + 128 + 16 * q) = (u32x4){pkbf(x[8 * q], x[8 * q + 1]), pkbf(x[8 * q + 2], x[8 * q + 3]), pkbf(x[8 * q + 4], x[8 * q + 5]), pkbf(x[8 * q + 6], x[8 * q + 7])}; }
          if (blk) {
#pragma unroll
              for (int q = 0; q < 4; ++q) { *(LAS u32x4*)(tp + 16 * q) = (u32x4){0u, 0u, 0u, 0u}; *(LAS u32x4*)(tpp + 16 * q) = (u32x4){0u, 0u, 0u, 0u}; } } }
        asm volatile("s_waitcnt lgkmcnt(0)" ::: "memory");
        const LAS unsigned char* xi = img + 128;
        f32x16 Pm; for (int q = 0; q < 16; ++q) Pm[q] = 0.f;
#pragma unroll
        for (int ks = 0; ks < 2; ++ks) { const LAS float* ar = Ad + (32 + r) * 68 + 16 * ks + 8 * hh; const f32x4 a0 = *(const LAS f32x4*)ar, a1 = *(const LAS f32x4*)(ar + 4);
            const bf16x8 af = __builtin_bit_cast(bf16x8, (u32x4){pkbf(a0[0], a0[1]), pkbf(a0[2], a0[3]), pkbf(a1[0], a1[1]), pkbf(a1[2], a1[3])});
            Pm = __builtin_amdgcn_mfma_f32_32x32x16_bf16(af, *(const LAS bf16x8*)(xi + r * TRS + (16 * ks + 8 * hh) * 2), Pm, 0, 0, 0); }
        f32x16 Tm; for (int q = 0; q < 16; ++q) Tm[q] = 0.f;
#pragma unroll
        for (int s = 0; s < 2; ++s) { const int l16 = lane & 15; const LAS unsigned char* p = xi + (32 + 16 * s + 4 * hh + (l16 >> 2)) * TRS + (16 * ((lane >> 4) & 1) + 4 * (l16 & 3)) * 2;
            const s16x4 lo = __builtin_amdgcn_ds_read_tr16_b64_v4i16((LAS s16x4*)p), hi = __builtin_amdgcn_ds_read_tr16_b64_v4i16((LAS s16x4*)(p + 8 * TRS));
            const bf16x8 af = (bf16x8){lo[0], lo[1], lo[2], lo[3], hi[0], hi[1], hi[2], hi[3]};
            const bf16x8 bfr = __builtin_bit_cast(bf16x8, (u32x4){pkbf(Pm[8 * s], Pm[8 * s + 1]), pkbf(Pm[8 * s + 2], Pm[8 * s + 3]), pkbf(Pm[8 * s + 4], Pm[8 * s + 5]), pkbf(Pm[8 * s + 6], Pm[8 * s + 7])});
            Tm = __builtin_amdgcn_mfma_f32_32x32x16_bf16(af, bfr, Tm, 0, 0, 0); }
        { const float b2 = -bt[dir * 64 + r], b1 = b2 * __expf(gct[dir * 64 + r]); const int tokc = dir ? 63 - r : r;
          LAS unsigned char* tp = img + tokc * TRS + (32 + 4 * hh) * 2; LAS unsigned char* tpp = tp + 64 * TRS;
#pragma unroll
          for (int g4 = 0; g4 < 4; ++g4) {
              *(LAS u32x2*)(tp + 16 * g4) = (u32x2){pkbf(Tm[4 * g4] * b1, Tm[4 * g4 + 1] * b1), pkbf(Tm[4 * g4 + 2] * b1, Tm[4 * g4 + 3] * b1)};
              *(LAS u32x2*)(tpp + 16 * g4) = (u32x2){pkbf(Tm[4 * g4] * b2, Tm[4 * g4 + 1] * b2), pkbf(Tm[4 * g4 + 2] * b2, Tm[4 * g4 + 3] * b2)}; } }
    }
    lds_bar();
#pragma unroll
    for (int k = 0; k < 2; ++k) { const int task = wave * 2 + k, dir = task >> 3, kind = (task >> 2) & 1, tl = task & 3;
        const LAS unsigned char* tim = lds + L_TPT + (2 * dir + kind) * 64 * TRS;
#pragma unroll
        for (int ti = 0; ti < 2; ++ti) { f32x16 c; for (int q = 0; q < 16; ++q) c[q] = 0.f;
            if (kind == 0) {
                const LAS unsigned char* ap = lds + L_KT + (32 * tl + r) * RS64 + 16 * hh;
#pragma unroll
                for (int ks = 0; ks < 4; ++ks) c = __builtin_amdgcn_mfma_f32_32x32x16_bf16(*(const LAS bf16x8*)(ap + 32 * ks), tr_frag(tim + (16 * ks + 8 * hh) * TRS + 64 * ti, TRS, lane), c, 0, 0, 0);
#pragma unroll
                for (int g = 0; g < 4; ++g) *(LAS u32x2*)(lds + (dir ? L_AT1 : L_AT0) + (32 * ti + r) * RS128 + (32 * tl + 8 * g + 4 * hh) * 2) = (u32x2){pkbf(c[4 * g], c[4 * g + 1]), pkbf(c[4 * g + 2], c[4 * g + 3])};
            } else {
                const LAS unsigned char* bp = lds + L_VT + (32 * tl + r) * RS64 + 16 * hh;
#pragma unroll
                for (int ks = 0; ks < 4; ++ks) c = __builtin_amdgcn_mfma_f32_32x32x16_bf16(tr_frag(tim + (16 * ks + 8 * hh) * TRS + 64 * ti, TRS, lane), *(const LAS bf16x8*)(bp + 32 * ks), c, 0, 0, 0);
                unsigned char* rec = recs + rec_off(b, h, cix, dir);
#pragma unroll
                for (int g = 0; g < 4; ++g) *(u32x2*)(rec + REC_UT + ((tl * 2 + ti) * 4 + g) * 512 + lane * 8) = (u32x2){pkbf(c[4 * g], c[4 * g + 1]), pkbf(c[4 * g + 2], c[4 * g + 3])};
            } }
    }
    lds_bar();
#pragma unroll
    for (int k = 0; k < 10; ++k) { const int ff = wave * 10 + k, dir = ff / 40, f = ff % 40; u32x2 lo, hi; unsigned char* dst; unsigned char* rec = recs + rec_off(b, h, cix, dir);
        if (f < 16) { const int rt = f >> 3, ks = f & 7; const LAS unsigned char* p = lds + (dir ? L_AT1 : L_AT0) + (32 * rt + r) * RS128 + (16 * ks + 4 * hh) * 2; lo = *(const LAS u32x2*)p; hi = *(const LAS u32x2*)(p + 16); dst = rec + REC_W + f * 1024; }
        else if (f < 24) { const int f2 = f - 16, rt = f2 >> 2, ks = f2 & 3; const LAS unsigned char* p = lds + L_ATT + dir * 9216 + (32 * rt + r) * RS64 + (16 * ks + 4 * hh) * 2; lo = *(const LAS u32x2*)p; hi = *(const LAS u32x2*)(p + 16); dst = rec + REC_AT + f2 * 1024; }
        else { if (dir == 1) continue;
            const int f2 = f - 24, kb = f2 >> 2, ks = f2 & 3; const LAS unsigned char* row = lds + L_KT + (32 * kb + r) * RS64;
            lo = *(const LAS u32x2*)(row + (16 * ks + 4 * hh) * 2); hi = *(const LAS u32x2*)(row + (16 * ks + 8 + 4 * hh) * 2);
            dst = rec + REC_KT + f2 * 1024; }
        *(u32x4*)(dst + lane * 16) = (u32x4){lo.x, lo.y, hi.x, hi.y}; }
    lds_bar();
}

constexpr int SB_UT = REC_UT, SB_SC = REC_UT + 8192, SB_BYTES = REC_UT + 8192 + 1024, SB_FRAGS = SB_BYTES / 1024;
GDN_DI int scan_cix(int dir, int n) { return dir == 0 ? n : (n < 4 ? 3 - n : 39 - n); }
GDN_DI void scan_load(LAS unsigned char* buf, const unsigned char* rec, const unsigned char* rec0, int dir, int sp, int lw  , int lane) {
    const int r = lane & 31, hh = lane >> 5;
#pragma unroll
    for (int k = 0; k < 11; ++k) { const int f = lw + 6 * k;
        if (f < SB_FRAGS) { const unsigned char* src;
            if (f >= 16 && f < 32) { const int f2 = f - 16, rt = f2 >> 3, ks = f2 & 7; src = dir ? rec0 + REC_Q + ((1 - rt) * 8 + ks) * 1024 + ((31 - r) + 32 * hh) * 16 : rec0 + REC_Q + f2 * 1024 + lane * 16; }
            else if (f >= 40 && f < 56) { const int f2 = f - 40, kb = f2 >> 2, ks = f2 & 3; src = dir ? rec0 + REC_KT + (kb * 4 + (3 - ks)) * 1024 + (r + 32 * (1 - hh)) * 16 : rec0 + REC_KT + f2 * 1024 + lane * 16; }
            else src = (f < 56 ? rec + f * 1024 : (f < 64 ? rec + REC_UT + sp * 8192 + (f - 56) * 1024 : rec + REC_SC)) + lane * 16;
            __builtin_amdgcn_global_load_lds((const unsigned*)src, (LAS unsigned*)(buf + f * 1024), 16, 0, 0); } }
}
GDN_DI void scan_wg(LAS unsigned char* lds, const unsigned char* recs, unsigned* og  , int b, int h, int dir, int sp, int tid) {
    const int lane = tid & 63, wave = __builtin_amdgcn_readfirstlane(tid >> 6), r = lane & 31, hh = lane >> 5, sl = 2 * sp + (wave & 1);
    f32x16 S[4];
#pragma unroll
    for (int k = 0; k < 4; ++k) for (int q = 0; q < 16; ++q) S[k][q] = 0.f;
    wg_bar();
    if (wave >= 2) scan_load(lds, recs + rec_off(b, h, scan_cix(dir, 0), dir), recs + rec_off(b, h, scan_cix(dir, 0), 0), dir, sp, wave - 2, lane);
    wg_bar();
    for (int n = 0; n < 36; ++n) {
        LAS unsigned char* buf = lds + (n & 1) * SB_BYTES;
        if (wave >= 2) { if (n + 1 < 36) scan_load(lds + ((n + 1) & 1) * SB_BYTES, recs + rec_off(b, h, scan_cix(dir, n + 1), dir), recs + rec_off(b, h, scan_cix(dir, n + 1), 0), dir, sp, wave - 2, lane); }
        else {
            const int cix = scan_cix(dir, n);
            const LAS unsigned char* fw = buf + REC_W + lane * 16; const LAS unsigned char* fq = buf + REC_Q + lane * 16;
            const LAS unsigned char* fa = buf + REC_AT + lane * 16; const LAS unsigned char* fk = buf + REC_KT + lane * 16;
            const LAS unsigned char* ut = buf + SB_UT + (wave & 1) * 4096 + lane * 8;
            const LAS float* sc = (const LAS float*)(buf + SB_SC);
            bf16x8 Sb[8];
#pragma unroll
            for (int kb = 0; kb < 4; ++kb)
#pragma unroll
                for (int s2 = 0; s2 < 2; ++s2) { u32x4 p; p.x = pkbf(S[kb][8 * s2], S[kb][8 * s2 + 1]); p.y = pkbf(S[kb][8 * s2 + 2], S[kb][8 * s2 + 3]); p.z = pkbf(S[kb][8 * s2 + 4], S[kb][8 * s2 + 5]); p.w = pkbf(S[kb][8 * s2 + 6], S[kb][8 * s2 + 7]);
                    Sb[2 * kb + s2] = __builtin_bit_cast(bf16x8, p); }
            f32x16 X[2], QS[2];
#pragma unroll
            for (int rt = 0; rt < 2; ++rt) { for (int q = 0; q < 16; ++q) { X[rt][q] = 0.f; QS[rt][q] = 0.f; }
#pragma unroll
                for (int ks = 0; ks < 8; ++ks) { X[rt] = __builtin_amdgcn_mfma_f32_32x32x16_bf16(*(const LAS bf16x8*)(fw + (rt * 8 + ks) * 1024), Sb[ks], X[rt], 0, 0, 0);
                    QS[rt] = __builtin_amdgcn_mfma_f32_32x32x16_bf16(*(const LAS bf16x8*)(fq + (rt * 8 + ks) * 1024), Sb[ks], QS[rt], 0, 0, 0); } }
            bf16x8 vb[4], veb[4];
#pragma unroll
            for (int rt = 0; rt < 2; ++rt)
#pragma unroll
                for (int s2 = 0; s2 < 2; ++s2) {
                    u32x4 pv, pe;
#pragma unroll
                    for (int gg = 0; gg < 2; ++gg) { const int g = 2 * s2 + gg;
                        const u32x2 uu = *(const LAS u32x2*)(ut + (rt * 4 + g) * 512);
                        const f32x4 ev = *(const LAS f32x4*)(sc + 64 + 32 * rt + 8 * g + 4 * hh);
                        const float u0 = __builtin_bit_cast(float, uu.x << 16), u1 = __builtin_bit_cast(float, uu.x & 0xffff0000u), u2 = __builtin_bit_cast(float, uu.y << 16), u3 = __builtin_bit_cast(float, uu.y & 0xffff0000u);
                        const float v0 = u0 - X[rt][4 * g], v1 = u1 - X[rt][4 * g + 1], v2 = u2 - X[rt][4 * g + 2], v3 = u3 - X[rt][4 * g + 3];
                        const unsigned a0 = pkbf(v0, v1), a1 = pkbf(v2, v3), e0 = pkbf(v0 * ev[0], v1 * ev[1]), e1 = pkbf(v2 * ev[2], v3 * ev[3]);
                        if (gg == 0) { pv.x = a0; pv.y = a1; pe.x = e0; pe.y = e1; } else { pv.z = a0; pv.w = a1; pe.z = e0; pe.w = e1; } }
                    vb[2 * rt + s2] = __builtin_bit_cast(bf16x8, pv); veb[2 * rt + s2] = __builtin_bit_cast(bf16x8, pe); }
            const int rbase = chunk_base(b, cix);
#pragma unroll
            for (int rt = 0; rt < 2; ++rt) {
#pragma unroll
                for (int g = 0; g < 4; ++g) { const f32x4 av = *(const LAS f32x4*)(sc + 32 * rt + 8 * g + 4 * hh);
                    QS[rt][4 * g] *= av[0]; QS[rt][4 * g + 1] *= av[1]; QS[rt][4 * g + 2] *= av[2]; QS[rt][4 * g + 3] *= av[3]; }
#pragma unroll
                for (int ks = 0; ks < 4; ++ks) QS[rt] = __builtin_amdgcn_mfma_f32_32x32x16_bf16(*(const LAS bf16x8*)(fa + (rt * 4 + ks) * 1024), vb[ks], QS[rt], 0, 0, 0);
#pragma unroll
                for (int q = 0; q < 16; q += 2) { const int rho = 32 * rt + (q & 3) + 8 * (q >> 2) + 4 * hh, tev = dir ? 62 - rho : rho;
                    og[(size_t)((rbase + tev) >> 1) * 1024 + h * 128 + 32 * sl + r] = dir ? pkbf(QS[rt][q + 1], QS[rt][q]) : pkbf(QS[rt][q], QS[rt][q + 1]); }
            }
            const float gl = sc[128];
#pragma unroll
            for (int kb = 0; kb < 4; ++kb) {
#pragma unroll
                for (int q = 0; q < 16; ++q) S[kb][q] *= gl;
#pragma unroll
                for (int ks = 0; ks < 4; ++ks) { u32x4 kf = *(const LAS u32x4*)(fk + (kb * 4 + ks) * 1024);
                    if (dir) kf = (u32x4){rot16(kf.w), rot16(kf.z), rot16(kf.y), rot16(kf.x)};
                    S[kb] = __builtin_amdgcn_mfma_f32_32x32x16_bf16(__builtin_bit_cast(bf16x8, kf), veb[ks], S[kb], 0, 0, 0); }
            }
        }
        if (wave >= 2) asm volatile("s_waitcnt vmcnt(0) lgkmcnt(0)" ::: "memory"); else asm volatile("s_waitcnt lgkmcnt(0)" ::: "memory");
        __builtin_amdgcn_s_barrier(); asm volatile("" ::: "memory");
    }
}
}
__device__ __forceinline__ void wconv_item(const float* W, int K, int N, act_t* dst, const Dims& d, int kind, LAS float* scr, int item, int lane) {
    const int nblk = N / 32; const int kb = item / nblk, nb = item % nblk, k0 = 64 * kb, n0 = 32 * nb;
    float wv[32];
#pragma unroll
    for (int i = 0; i < 32; ++i) wv[i] = __builtin_nontemporal_load(&W[(size_t)(k0 + 2 * i + (lane >> 5)) * N + n0 + (lane & 31)]);
#pragma unroll
    for (int i = 0; i < 32; ++i) scr[(2 * i + (lane >> 5)) * 33 + (lane & 31)] = wv[i];
    asm volatile("s_waitcnt lgkmcnt(0)" ::: "memory");
    const int c = lane & 7;
#pragma unroll
    for (int j = 0; j < 4; ++j) { const int n = (lane >> 3) + 8 * j; const LAS float* s = scr + (8 * c) * 33 + n;
        v4u o; o.x = pk2(s[0 * 33], s[1 * 33]); o.y = pk2(s[2 * 33], s[3 * 33]); o.z = pk2(s[4 * 33], s[5 * 33]); o.w = pk2(s[6 * 33], s[7 * 33]);
        *(v4u*)(dst + (size_t)w_dstrow(d, kind, n0 + n) * K + k0 + 8 * c) = o; }
    asm volatile("s_waitcnt lgkmcnt(0)" ::: "memory");
}
template <int kind> __device__ __forceinline__ void ph_wconv(const Frame& F, const Params& P, const Dims& d, int layer) {
    const int tid = fresh_tid(), lane = tid & 63, wave = __builtin_amdgcn_readfirstlane(tid >> 6), bid = fresh_bid();
    LAS float* scr = (LAS float*)(F.lds + wave * 8448);
    const float* W; int K, N; act_t* dst; w_src(P, d, kind, layer, W, K, N, dst);
    const int nitems = (K / 64) * (N / 32);
    for (int item = bid * NWAVES + wave; item < nitems; item += F.G * NWAVES) wconv_item(W, K, N, dst, d, kind, scr, item, lane);
}
__device__ __forceinline__ void ph_wconv_queue(const Frame& F, const Params& P, const Dims& d, int layer, unsigned* ticket, int part = 0) {
    const int tid = fresh_tid(), lane = tid & 63, wave = __builtin_amdgcn_readfirstlane(tid >> 6);
    LAS float* scr = (LAS float*)(F.lds + wave * 8448); volatile LAS unsigned* tk = (volatile LAS unsigned*)(F.lds + 8 * 8448);
    const int nOut = (d.D / 64) * (d.D / 32), nGU = (d.D / 64) * (d.FF / 32), nDn = (d.FF / 64) * (d.D / 32), total = part == 1 ? nOut + 2 * nGU : nOut + 2 * nGU + nDn, first = part == 2 ? nOut + 2 * nGU : 0;
    for (;;) {
        asm volatile("s_waitcnt lgkmcnt(0)" ::: "memory"); __builtin_amdgcn_s_barrier(); asm volatile("" ::: "memory");
        if (tid == 0) tk[0] = __hip_atomic_fetch_add(ticket, 8u, __ATOMIC_RELAXED, __HIP_MEMORY_SCOPE_AGENT);
        asm volatile("s_waitcnt vmcnt(0) lgkmcnt(0)" ::: "memory"); __builtin_amdgcn_s_barrier(); asm volatile("" ::: "memory");
        const int base = (int)tk[0] + first; if (base >= total) break;
        int it = base + wave; if (it >= total) continue;
        if (it < nOut) wconv_item(P.w_out + (size_t)layer * d.D * d.D, d.D, d.D, P.wt_out, d, WK_OUT, scr, it, lane);
        else if ((it -= nOut) < nGU) wconv_item(P.ffn_wg + (size_t)layer * d.D * d.FF, d.D, d.FF, P.wt_gu, d, WK_GATE, scr, it, lane);
        else if ((it -= nGU) < nGU) wconv_item(P.ffn_wu + (size_t)layer * d.D * d.FF, d.D, d.FF, P.wt_gu, d, WK_UP, scr, it, lane);
        else wconv_item(P.ffn_wd + (size_t)layer * d.FF * d.D, d.FF, d.D, P.wt_dn, d, WK_DOWN, scr, it - nGU, lane);
    }
}
__device__ __forceinline__ void ph_norm(const Frame& F, const Params& P, const Dims& d, int layer, int which, int nrows, const float* part = nullptr, int src0 = 0) {
    const int tid = fresh_tid(), lane = tid & 63, wave = __builtin_amdgcn_readfirstlane(tid >> 6), bid = fresh_bid();
    for (int row = bid * NWAVES + wave; row < nrows; row += F.G * NWAVES) {
        const float* hsrc = nullptr;
        if (src0 == 1 && row < d.ML) hsrc = P.x + (size_t)row * d.D;
        if (src0 >= 1 && row >= d.ML) hsrc = P.ctx + (size_t)(row - d.ML) * d.D;
        f32x4 v[8]; float ss = 0.f;
        if (hsrc != nullptr) { const f32x4* hr = (const f32x4*)hsrc + lane;
#pragma unroll
            for (int j = 0; j < 8; ++j) v[j] = hr[64 * j];
        } else { const v2u* hr = (const v2u*)(P.hb + (size_t)row * d.D) + lane;
#pragma unroll
            for (int j = 0; j < 8; ++j) { const v2u w = hr[64 * j];
                v[j] = (f32x4){__builtin_bit_cast(float, w.x << 16), __builtin_bit_cast(float, w.x & 0xffff0000u), __builtin_bit_cast(float, w.y << 16), __builtin_bit_cast(float, w.y & 0xffff0000u)}; } }
        if (part != nullptr && row >= d.ML) {
#pragma unroll
            for (int p4 = 0; p4 < 4; ++p4) { const v2u* pr = (const v2u*)((const bf16_t*)part + ((size_t)p4 * d.MC + (row - d.ML)) * d.D) + lane;
#pragma unroll
                for (int j = 0; j < 8; ++j) { const v2u w = pr[64 * j];
                    v[j] = v[j] + (f32x4){__builtin_bit_cast(float, w.x << 16), __builtin_bit_cast(float, w.x & 0xffff0000u), __builtin_bit_cast(float, w.y << 16), __builtin_bit_cast(float, w.y & 0xffff0000u)}; } }
            v2u* hw = (v2u*)(P.hb + (size_t)row * d.D) + lane;
#pragma unroll
            for (int j = 0; j < 8; ++j) hw[64 * j] = (v2u){pk2(v[j].x, v[j].y), pk2(v[j].z, v[j].w)};
        }
#pragma unroll
        for (int j = 0; j < 8; ++j) ss += (v[j].x * v[j].x + v[j].y * v[j].y) + (v[j].z * v[j].z + v[j].w * v[j].w);
        const float r = 1.0f / sqrtf(wave_sum(ss) / (float)d.D + 1e-6f);
        if (which == 2) {
            f32x4* o = (f32x4*)(P.out + (size_t)row * d.D) + lane; const f32x4* g = (const f32x4*)P.final_g + lane;
#pragma unroll
            for (int j = 0; j < 8; ++j) o[64 * j] = v[j] * r * g[64 * j];
        } else {
            const int b9 = row < d.ML ? row / d.S : d.B;
            const float* mv = P.modv + ((size_t)layer * (d.B + 1) + b9) * 6 * d.D;
            const f32x4* g = (const f32x4*)((which ? P.norm_ffn_g : P.norm_mix_g) + (size_t)layer * d.D) + lane;
            const f32x4* sh = (const f32x4*)(mv + (which ? 3 : 0) * d.D) + lane; const f32x4* sc = (const f32x4*)(mv + (which ? 4 : 1) * d.D) + lane;
            unsigned long long* o8 = (unsigned long long*)(P.u + (size_t)row * d.D) + lane;
#pragma unroll
            for (int j = 0; j < 8; ++j) { const f32x4 t = v[j] * r * g[64 * j] * (sc[64 * j] + 1.0f) + sh[64 * j];
                o8[64 * j] = (unsigned long long)pk2(t.x, t.y) | ((unsigned long long)pk2(t.z, t.w) << 32); }
        }
    }
}


__device__ __forceinline__ void ab_unit(const bf16_t* u, const bf16_t* wab  , float* ab, int rowtile, int tid) {
    const int lane = tid & 63, wave = __builtin_amdgcn_readfirstlane(tid >> 6), r = lane & 31, hh = lane >> 5;
    const bf16_t* ap = u + (size_t)(rowtile * 256 + wave * 32 + r) * 2048 + 8 * hh;
    const bf16_t* bp = wab + (size_t)r * 2048 + 8 * hh;
    att::f32x16 c; for (int q = 0; q < 16; ++q) c[q] = 0.f;
#pragma unroll 8
    for (int ks = 0; ks < 128; ++ks) c = __builtin_amdgcn_mfma_f32_32x32x16_bf16(*(const att::bf16x8*)(ap + 16 * ks), *(const att::bf16x8*)(bp + 16 * ks), c, 0, 0, 0);
    float* op = ab + (size_t)(rowtile * 256 + wave * 32) * 32 + r;
#pragma unroll
    for (int q = 0; q < 16; ++q) op[((q & 3) + 8 * (q >> 2) + 4 * hh) * 32] = c[q];
}
__device__ __forceinline__ void ph_mod(const Frame& F, const Params& P, const Dims& d, int l, unsigned* ticket) {
    const int tid = fresh_tid(), lane = tid & 63, wave = __builtin_amdgcn_readfirstlane(tid >> 6);
    LAS float* sil = (LAS float*)F.lds;
    LAS float* part = (LAS float*)(F.lds + 9 * 2048 * 4);
    volatile LAS unsigned* tk = (volatile LAS unsigned*)(F.lds + 9 * 2048 * 4 + 8 * 9 * 64 * 4);
    bool have_sil = false;
    for (;;) {
        asm volatile("s_waitcnt lgkmcnt(0)" ::: "memory"); __builtin_amdgcn_s_barrier(); asm volatile("" ::: "memory");
        if (tid == 0) tk[0] = __hip_atomic_fetch_add(ticket, 1u, __ATOMIC_RELAXED, __HIP_MEMORY_SCOPE_AGENT);
        asm volatile("s_waitcnt vmcnt(0) lgkmcnt(0)" ::: "memory"); __builtin_amdgcn_s_barrier(); asm volatile("" ::: "memory");
        const int it = (int)tk[0]; if (it >= 192) break;
        if (!have_sil) { have_sil = true;
            for (int i = tid; i < 9 * 2048; i += NTHR) { const int b9 = i >> 11, k = i & 2047; const float c = b9 < 8 ? P.c[b9 * 2048 + k] : P.c_ctx[k]; sil[i] = c / (1.0f + __expf(-c)); }
            asm volatile("s_waitcnt lgkmcnt(0)" ::: "memory"); __builtin_amdgcn_s_barrier(); asm volatile("" ::: "memory"); }
        const int n0 = it * 64;
        const float* w = P.ada_w + ((size_t)l * 2048 + 256 * wave) * 12288 + n0 + lane;
        float acc[9];
#pragma unroll
        for (int b = 0; b < 9; ++b) acc[b] = 0.f;
        float wa[16], wb[16]; const LAS float* sw = sil + 256 * wave;
#pragma unroll
        for (int i = 0; i < 16; ++i) wa[i] = __builtin_nontemporal_load(&w[(size_t)i * 12288]);
#pragma unroll 1
        for (int k0 = 0; k0 < 256; k0 += 32) {
#pragma unroll
            for (int i = 0; i < 16; ++i) wb[i] = __builtin_nontemporal_load(&w[(size_t)(k0 + 16 + i) * 12288]);
#pragma unroll
            for (int i = 0; i < 16; ++i) {
#pragma unroll
                for (int b = 0; b < 9; ++b) acc[b] += sw[b * 2048 + k0 + i] * wa[i]; }
            if (k0 + 32 < 256) {
#pragma unroll
                for (int i = 0; i < 16; ++i) wa[i] = __builtin_nontemporal_load(&w[(size_t)(k0 + 32 + i) * 12288]); }
#pragma unroll
            for (int i = 0; i < 16; ++i) {
#pragma unroll
                for (int b = 0; b < 9; ++b) acc[b] += sw[b * 2048 + k0 + 16 + i] * wb[i]; }
        }
#pragma unroll
        for (int b = 0; b < 9; ++b) part[(wave * 9 + b) * 64 + lane] = acc[b];
        asm volatile("s_waitcnt lgkmcnt(0)" ::: "memory"); __builtin_amdgcn_s_barrier(); asm volatile("" ::: "memory");
        for (int o = tid; o < 9 * 64; o += NTHR) { const int b = o >> 6, cl = o & 63; float s = P.ada_b[(size_t)l * 12288 + n0 + cl];
#pragma unroll
            for (int ks = 0; ks < 8; ++ks) s += part[(ks * 9 + b) * 64 + cl];
            P.modv[((size_t)l * 9 + b) * 12288 + n0 + cl] = s; }
    }
}
__device__ __forceinline__ void ph_merge_even(const Frame& F, const Params& P, const Dims& d, int layer, int nrows) {
    const int tid = fresh_tid(), lane = tid & 63, wave = __builtin_amdgcn_readfirstlane(tid >> 6), bid = fresh_bid();
    const int i2 = layer >> 1;
    typedef float f2 __attribute__((ext_vector_type(2)));
    const f2 gg = *(const f2*)(P.gdn_norm_g + i2 * 128 + 2 * lane);
    const unsigned* og0 = (const unsigned*)P.ogdn; const unsigned* og1 = og0 + (size_t)(d.M / 2) * 1024;
    for (int pair = bid * NWAVES + wave; pair < nrows / 2; pair += F.G * NWAVES) {
        const v2u* a0 = (const v2u*)(og0 + (size_t)pair * 1024) + lane; const v2u* a1 = (const v2u*)(og1 + (size_t)pair * 1024) + lane;
#pragma unroll
        for (int hs = 0; hs < 8; ++hs) {
            const v2u a = a0[hs * 64], b = a1[hs * 64];
#pragma unroll
            for (int rr = 0; rr < 2; ++rr) { const int row = 2 * pair + rr;
                const float ax = rr ? __builtin_bit_cast(float, a.x & 0xffff0000u) : __builtin_bit_cast(float, a.x << 16), ay = rr ? __builtin_bit_cast(float, a.y & 0xffff0000u) : __builtin_bit_cast(float, a.y << 16);
                const float bx = rr ? __builtin_bit_cast(float, b.x & 0xffff0000u) : __builtin_bit_cast(float, b.x << 16), by = rr ? __builtin_bit_cast(float, b.y & 0xffff0000u) : __builtin_bit_cast(float, b.y << 16);
                const f2 o = {ax + bx, ay + by};
                const float r = 1.0f / sqrtf(wave_sum(o.x * o.x + o.y * o.y) * (1.0f / 128.f) + 1e-6f);
                const bf16_t* zp = P.proj + (size_t)row * d.NPE + d.PZ + 2 * lane; bf16_t* yp = P.y + (size_t)row * 2048 + 2 * lane;
                const unsigned zz = *(const unsigned*)(zp + hs * 128); const float z0 = __builtin_bit_cast(float, zz << 16), z1 = __builtin_bit_cast(float, zz & 0xffff0000u);
                *(unsigned*)(yp + hs * 128) = pk2(o.x * r * gg.x * (z0 / (1.0f + __expf(-z0))), o.y * r * gg.y * (z1 / (1.0f + __expf(-z1)))); }
        }
    }
}

template <int V> struct IC { static constexpr int value = V; };
__global__ void __launch_bounds__(NTHR, 2) mk_fwd(KArgs KA) {
    constexpr Dims d = DF;
    extern __shared__ __attribute__((aligned(16))) unsigned char lds_raw[];
    Frame F; F.lds = (LAS unsigned char*)lds_raw; F.G = gridDim.x;
    for (int u = threadIdx.x; u < (LDS_BYTES - LDS_CTL) / 4; u += NTHR) ((LAS unsigned*)(F.lds + LDS_CTL))[u] = 0u;
    __syncthreads();
    const unsigned bar_x = xcd_barrier_post((unsigned*)(KA.ws + WS_CTL) + CW_BAR, (volatile LAS unsigned*)(F.lds + LDS_CTL)).x;
#define GRID_BAR() do { XcdBarrier b_; unsigned char* w_ = KA.ws; asm volatile("" : "+s"(w_)); unsigned x_ = bar_x; asm volatile("" : "+s"(x_)); \
        b_.bar = (unsigned*)(w_ + WS_CTL) + CW_BAR; b_.x = x_; b_.st = (volatile LAS unsigned*)(F.lds + LDS_CTL); xcd_barrier(b_); if (DUPMASK & 128) xcd_barrier(b_); } while (0)
    const int H1 = d.HS * 128; (void)H1;
    { const Params P = mk_params(KA); ph_mod(F, P, d, 0, P.ctl + 32768 + 64 * 8); }
    { const Params P = mk_params(KA); NAIVE_IDS(); st_rope_tab(P, d, 0, gid_, nth_); }
    GRID_BAR();
    auto layer_ = [&](auto LC_) {
        constexpr int l = decltype(LC_)::value;
        constexpr bool even = (l & 1) == 0, need_ctx = l < d.DEPTH - 1; const int Mr = need_ctx ? d.M : d.ML; const int NP = even ? d.NPE : d.NPO;
        DUP(2) {
        if (even) { ph_wconv<WK_IN_EVEN>(F, mk_params(KA), d, l); { const Params P = mk_params(KA); NAIVE_IDS(); st_wpad_even(P, d, l, gid_, nth_); } } else ph_wconv<WK_IN_ODD>(F, mk_params(KA), d, l);
        { const Params P = mk_params(KA); ph_norm(F, P, d, l, 0, d.M, l >= 1 ? P.ogdn : nullptr, l == 0 ? 1 : 0); }
        }
        GRID_BAR();
        { auto phB_ = [&]() { const Params P = mk_params(KA); pg8::Gemm g; g.A = P.u; g.Bt = P.wt_in; g.M = d.M; g.N = NP; g.K = d.D; pg8::StaticOrder S; S.init(g.M, g.N, F.G, fresh_bid(), g.K);
          pg8::EpiProj E; E.O = P.proj; E.ldc = NP; E.ab = P.ab; E.abw = d.ABW; E.ab_tile = even ? d.PA / 256 : -1;
          E.rope_lo = even ? d.PDQ / 256 : d.PWQ / 256; E.rope_hi = even ? d.PDV / 256 : d.PWV / 256; E.rope_n2 = even ? 16 : 32; E.rope_tab = even ? P.rope32 : P.rope64;
          pg8::gemm_phase<pg8::EpiProj, pg8::StaticOrder, true, true>(F.lds, g, S, E); };
          phB_(); if (DUPMASK & 64) phB_(); }
        { const Params P = mk_params(KA); ph_wconv_queue(F, P, d, l, P.ctl + 32768 + 64 * l, need_ctx ? 1 : 0); }
        GRID_BAR();
        if (even) {
            DUP(4) {
                const Params P = mk_params(KA); const int tid = fresh_tid(), bid = fresh_bid();
                for (int it = bid; it < 2304; it += F.G) { const int cix = it % 36, hh = (it / 36) & 7, bb = it / 288;
                    gdn::g1_item(F.lds, P.proj, P.ab, P.gdn_conv_w + (size_t)(l >> 1) * 9216, P.gdn_a_log + (l >> 1) * 16, P.gdn_dt_bias + (l >> 1) * 16, (unsigned char*)P.u, bb, hh, cix, tid); }
            }
            GRID_BAR();
            DUP(16) {
                const Params P = mk_params(KA); const int tid = fresh_tid(), bid = fresh_vbid(F.G);
                for (int task = bid; task < 256; task += F.G) { const int sp = task & 1, dir = (task >> 1) & 1, hh = (task >> 2) & 7, bb = task >> 5;
                    gdn::scan_wg(F.lds, (const unsigned char*)P.u, (unsigned*)P.ogdn + (size_t)dir * (d.M / 2) * 1024, bb, hh, dir, sp, tid); }
            }
            DUP(8) {
                const Params P = mk_params(KA); const int tid = fresh_tid(), bid = fresh_vbid(F.G); const int nu = 512 + (need_ctx ? 64 : 0);
                const float lam = diff_lambda(P, l), li = lambda_init_of(l); const int grp = att::simd_rank(F.lds + LDS_CTL + 64, tid);
                for (int ui = bid; ui < nu; ui += F.G) {
                    att::DiffU u; u.q = P.proj + d.PDQ; u.k = P.proj + d.PDK; u.v = P.proj + d.PDV; u.o = P.odiff; u.y = P.y; u.subg = P.subln_g + (l >> 1) * 128; u.lam = lam; u.outscale = 1.0f - li;
                    if (ui < 512) { const int qt = ui & 7; u.head = (ui >> 3) & 7; u.b = ui >> 6; u.qrow0 = u.b * 2048 + 256 * qt; u.lat = 1; }
                    else { const int j = ui - 512; u.head = j & 7; u.b = j >> 3; u.qrow0 = 16384 + u.b * 256; u.lat = 0; }
                    u.c = 0; att::run_unit<64>(F.lds, u, tid, grp);
                    u.c = 1; att::run_unit<64>(F.lds, u, tid, grp);
                }
                if (need_ctx) ph_wconv_queue(F, P, d, l, P.ctl + 32768 + 64 * (16 + l), 2);
            }
            GRID_BAR();
            DUP(1) ph_merge_even(F, mk_params(KA), d, l, Mr);
        } else {
            DUP(8) {
                const Params P = mk_params(KA); const int tid = fresh_tid(), bid = fresh_vbid(F.G); const int nu = 512 + (need_ctx ? 64 : 0);
                LAS float* rpb_l = (LAS float*)(F.lds + att::Geo<128>::TOTAL); const int grp = att::simd_rank(F.lds + LDS_CTL + 64, tid);
                for (int ui = bid; ui < nu; ui += F.G) {
                    att::NaU u; u.proj = P.proj; u.y = P.y; u.rpb = rpb_l;
                    if (ui < 512) { u.R = ui & 7; u.head = (ui >> 3) & 7; u.b = ui >> 6; u.lat = 1; const int a0 = 4 * u.R - 4, a1 = 4 * u.R - 1;
                        u.lo = a0 < 0 ? 0 : (a0 > 24 ? 24 : a0); u.nloc = (a1 < 0 ? 0 : (a1 > 24 ? 24 : a1)) + 7 - u.lo + 1; }
                    else { const int j = ui - 512; u.head = j & 7; u.b = j >> 3; u.R = 0; u.lat = 0; u.lo = 0; u.nloc = 0; }
                    asm volatile("s_waitcnt lgkmcnt(0)" ::: "memory"); __builtin_amdgcn_s_barrier(); asm volatile("" ::: "memory");
                    if (tid < 465) rpb_l[tid] = P.na_rpb[((size_t)(l >> 1) * 8 + u.head) * 465 + tid] * att::L2E;
                    att::run_unit<128>(F.lds, u, tid, grp);
                }
            }
            DUP(8) {
                const Params P = mk_params(KA); const int tid = fresh_tid(), bid = fresh_vbid(F.G); const int nu = 512 + (need_ctx ? 64 : 0); const int grp = att::simd_rank(F.lds + LDS_CTL + 64, tid);
                for (int ui = bid; ui < nu; ui += F.G) {
                    att::WinU u; u.q = P.proj + d.PWQ; u.k = P.proj + d.PWK; u.v = P.proj + d.PWV; u.y = P.y; u.sink = P.win_sink + (l >> 1) * 8;
                    if (ui < 512) { u.qb = ui & 31; u.kvh = (ui >> 5) & 1; u.b = ui >> 6; u.lat = 1; u.lo = u.qb - 2 < 0 ? 0 : u.qb - 2; const int hi = u.qb + 2 > 31 ? 31 : u.qb + 2; u.nloc = hi - u.lo + 1; }
                    else { const int j = ui - 512; u.qb = j & 3; u.kvh = (j >> 2) & 1; u.b = j >> 3; u.lat = 0; u.lo = 0; u.nloc = 0; }
                    att::run_unit<128>(F.lds, u, tid, grp);
                }
                if (need_ctx) ph_wconv_queue(F, P, d, l, P.ctl + 32768 + 64 * (16 + l), 2);
            }
        }
        GRID_BAR();
        { const Params P = mk_params(KA); pg8::Gemm g; g.A = P.y; g.Bt = P.wt_out; g.M = Mr; g.N = d.D; g.K = d.D; pg8::SplitOrder S; S.init(d.ML, Mr, g.N, F.G, fresh_bid(), g.K, 4);
          pg8::EpiResidT<l == 0> E; E.H = P.hb; E.Hin32 = P.x; E.ldc = d.D; E.gate0 = P.modv + (size_t)l * (d.B + 1) * 6 * d.D + 2 * d.D; E.S = d.S; E.ML = d.ML; E.B = d.B; E.D6 = 6 * d.D; E.part = P.ogdn;
          pg8::gemm_phase<pg8::EpiResidT<l == 0>, pg8::SplitOrder, true, true>(F.lds, g, S, E);
          if (DUPMASK & 256) { E.gate0 = (const float*)(P.ctl + 16384); E.D6 = 0; E.part = P.odiff; pg8::gemm_phase<pg8::EpiResidT<l == 0>, pg8::SplitOrder, true, true>(F.lds, g, S, E); } }
        GRID_BAR();
        { const Params P = mk_params(KA); ph_norm(F, P, d, l, 1, Mr, need_ctx ? P.ogdn : nullptr, l == 0 ? 2 : 0); }
        if (DUPMASK & 4096) { const Params P = mk_params(KA); ph_norm(F, P, d, l, 1, Mr, nullptr, 0); }
        GRID_BAR();
        { int fmode_ = 0; auto phF_ = [&]() { const Params P = mk_params(KA); pg8::Gemm g; g.A = P.u; g.Bt = P.wt_gu; g.M = Mr; g.N = 2 * d.FF; g.K = d.D; pg8::StaticOrder S; S.init(g.M, g.N, F.G, fresh_bid(), g.K);
          pg8::EpiSwiGLU E; E.O = P.hid; E.ldc = d.FF; E.mode = fmode_;
          pg8::gemm_phase<pg8::EpiSwiGLU, pg8::StaticOrder, true, true>(F.lds, g, S, E); };
          phF_(); if (DUPMASK & 32) phF_(); if (DUPMASK & 1024) { fmode_ = 1; phF_(); } if (DUPMASK & 2048) { fmode_ = 2; phF_(); } }
        if (l + 1 < d.DEPTH) { const Params P = mk_params(KA); ph_mod(F, P, d, l + 1, P.ctl + 32768 + 64 * (9 + l)); }
        GRID_BAR();
        { const Params P = mk_params(KA); pg8::Gemm g; g.A = P.hid; g.Bt = P.wt_dn; g.M = Mr; g.N = d.D; g.K = d.FF; pg8::SplitOrder S; S.init(d.ML, Mr, g.N, F.G, fresh_bid(), g.K, 4);
          pg8::EpiResidT<false> E; E.H = P.hb; E.Hin32 = nullptr; E.ldc = d.D; E.gate0 = P.modv + (size_t)l * (d.B + 1) * 6 * d.D + 5 * d.D; E.S = d.S; E.ML = d.ML; E.B = d.B; E.D6 = 6 * d.D; E.part = P.ogdn;
          pg8::gemm_phase<pg8::EpiResidT<false>, pg8::SplitOrder, true, true>(F.lds, g, S, E);
          if (DUPMASK & 512) { E.gate0 = (const float*)(P.ctl + 16384); E.D6 = 0; E.part = P.odiff; pg8::gemm_phase<pg8::EpiResidT<false>, pg8::SplitOrder, true, true>(F.lds, g, S, E); } }
        GRID_BAR();
    };
    layer_(IC<0>{}); layer_(IC<1>{}); layer_(IC<2>{}); layer_(IC<3>{});
    ph_norm(F, mk_params(KA), d, 0, 2, d.ML);
}

extern "C" void kernel_launch(void* const* d_in, const int* in_sizes, int n_in, void* d_out, int out_size, void* d_ws, size_t ws_size, hipStream_t stream) {
    static int grid = 0;
    if (WS_END > ws_size || n_in != 26) { fprintf(stderr, "kernel_launch: workspace too small (%zu needed, %zu given) or n_in %d != 26\n", (size_t)WS_END, ws_size, n_in); return; }
    KArgs a; memset(&a, 0, sizeof(a));
    for (int i = 0; i < 26; ++i) a.in[i] = (const float*)d_in[i];
    a.out = (float*)d_out; a.ws = (unsigned char*)d_ws;
    if (grid == 0) {
        int dev = 0, cus = 0, per_cu = 0;
        if (hipGetDevice(&dev) != hipSuccess || hipDeviceGetAttribute(&cus, hipDeviceAttributeMultiprocessorCount, dev) != hipSuccess) { fprintf(stderr, "kernel_launch: device query failed\n"); grid = -1; return; }
        if (hipFuncSetAttribute((const void*)mk_fwd, hipFuncAttributeMaxDynamicSharedMemorySize, LDS_BYTES) != hipSuccess) { fprintf(stderr, "kernel_launch: hipFuncSetAttribute failed\n"); grid = -1; return; }
        if (hipOccupancyMaxActiveBlocksPerMultiprocessor(&per_cu, (const void*)mk_fwd, NTHR, LDS_BYTES) != hipSuccess || per_cu < 1) { fprintf(stderr, "kernel_launch: occupancy query says %d blocks per CU\n", per_cu); }
        (void)hipGetLastError();
        grid = cus;
    }
    if (grid < 0) return;
    (void)hipMemsetAsync((unsigned char*)d_ws + WS_CTL, 0, 512 * 1024, stream);
    hipLaunchKernelGGL(mk_fwd, dim3(grid), dim3(NTHR), LDS_BYTES, stream, a);
}
#endif
```
